# Optimizing an MI355X kernel written in HIP

```python
import jax
import jax.numpy as jnp
from jax import lax
import numpy as np

D_MODEL = 2048
BATCH = 32
SEQ = 256
DEPTH = 2
DEC_BATCH = 8
DEC_SEQ = 4096
PAST_LEN = 512

GRID_W = 64
HEAD_DIM = 64
A_HEADS = 12
A_KV_HEADS = 4
A_GROUP = A_HEADS // A_KV_HEADS
A_WIDTH = A_HEADS * HEAD_DIM
A_KV_WIDTH = A_KV_HEADS * HEAD_DIM
A_WINDOW = 128
A_BLOCK = 128
B_WIDTH = 512
HYENA_ORDER = 2
HYENA_BANDS = 16
HYENA_EMB = 1 + 2 * HYENA_BANDS
HYENA_HIDDEN = 64
SHORT_CONV = 3
C_HEADS = 12
C_WIDTH = C_HEADS * HEAD_DIM
NA_ROWS = 8
NA_COLS = 16
Q_BLOCK = 128
ROPE_BASE = 10000.0
EPS = 1e-6
NEG_INF = -1e30
N_BRANCH = 3
IN_SPLITS = (A_WIDTH, A_KV_WIDTH, A_KV_WIDTH, A_WIDTH, 3 * B_WIDTH, B_WIDTH, 3 * C_WIDTH, C_WIDTH, N_BRANCH * D_MODEL)
IN_WIDTH = sum(IN_SPLITS)
IN_OFFSETS = tuple(int(o) for o in np.cumsum(IN_SPLITS)[:-1])

kernel_name = "hybrid_diffusion_prefix_trunk_step"

F32 = jnp.float32


def rms_norm(x, w):
    xf = x.astype(F32)
    y = xf * lax.rsqrt(jnp.mean(xf * xf, axis=-1, keepdims=True) + EPS)
    return (y * w.astype(F32)).astype(x.dtype)


def axial_rope(L):
    t = jnp.arange(L)
    row = (t // GRID_W).astype(F32)
    col = (t % GRID_W).astype(F32)
    nf = HEAD_DIM // 4
    inv = jnp.power(ROPE_BASE, -jnp.arange(nf, dtype=F32) / nf)
    ang = jnp.concatenate([row[:, None] * inv[None], col[:, None] * inv[None]], axis=-1)
    return jnp.cos(ang), jnp.sin(ang)


def apply_rope(x, cos, sin):
    xf = x.astype(F32)
    half = HEAD_DIM // 2
    x1, x2 = xf[..., :half], xf[..., half:]
    c = cos[None, :, None, :]
    s = sin[None, :, None, :]
    return jnp.concatenate([x1 * c - x2 * s, x1 * s + x2 * c], axis=-1).astype(x.dtype)


def project(x, cond, p):
    mod = jnp.matmul(jax.nn.silu(cond), p["w_ada"]) + p["b_ada"]
    shift, scale, gate = jnp.split(mod, 3, axis=-1)
    h = rms_norm(x, p["norm_w"]) * (1 + scale) + shift
    u = jnp.matmul(h, p["w_in"])
    return jnp.split(u, list(IN_OFFSETS), axis=-1), gate


def context_attn(q, k, v, sink):
    Bn, S, Hk, G, dh = q.shape
    nb = S // Q_BLOCK
    scale = dh ** -0.5
    qb = jnp.moveaxis(q.reshape(Bn, nb, Q_BLOCK, Hk, G, dh), 1, 0)

    def block(qi):
        s = jnp.einsum('bqkgd,bskd->bkgqs', qi, k, preferred_element_type=F32) * scale
        if sink is not None:
            sk = jnp.broadcast_to(sink.astype(F32)[None, :, :, None, None], s.shape[:-1] + (1,))
            pr = jax.nn.softmax(jnp.concatenate([s, sk], axis=-1), axis=-1)[..., :S]
        else:
            pr = jax.nn.softmax(s, axis=-1)
        return jnp.einsum('bkgqs,bskd->bqkgd', pr.astype(v.dtype), v)

    o = lax.map(block, qb)
    return jnp.moveaxis(o, 0, 1).reshape(Bn, S, Hk * G * dh)


def window_attn_latent(q, k, v, ctx_k, ctx_v, sink):
    Bn, L, Hk, G, dh = q.shape
    P = ctx_k.shape[1]
    nb = L // A_BLOCK
    span = A_BLOCK + 2 * A_WINDOW
    scale = dh ** -0.5
    pad = ((0, 0), (A_WINDOW, A_WINDOW), (0, 0), (0, 0))
    kp = jnp.pad(k, pad)
    vp = jnp.pad(v, pad)
    qb = jnp.moveaxis(q.reshape(Bn, nb, A_BLOCK, Hk, G, dh), 1, 0)
    sink32 = sink.astype(F32)[None, :, :, None, None]

    def block(args):
        i, qi = args
        start = i * A_BLOCK
        kb = lax.dynamic_slice_in_dim(kp, start, span, axis=1)
        vb = lax.dynamic_slice_in_dim(vp, start, span, axis=1)
        qpos = start + jnp.arange(A_BLOCK)
        kpos = start - A_WINDOW + jnp.arange(span)
        valid = (jnp.abs(qpos[:, None] - kpos[None, :]) <= A_WINDOW) & (kpos >= 0)[None, :] & (kpos < L)[None, :]
        s_loc = jnp.einsum('bqkgd,bskd->bkgqs', qi, kb, preferred_element_type=F32) * scale
        s_loc = jnp.where(valid, s_loc, NEG_INF)
        s_ctx = jnp.einsum('bqkgd,bpkd->bkgqp', qi, ctx_k, preferred_element_type=F32) * scale
        sk = jnp.broadcast_to(sink32, s_loc.shape[:-1] + (1,))
        pr = jax.nn.softmax(jnp.concatenate([s_loc, s_ctx, sk], axis=-1), axis=-1).astype(v.dtype)
        return (jnp.einsum('bkgqs,bskd->bqkgd', pr[..., :span], vb)
                + jnp.einsum('bkgqp,bpkd->bqkgd', pr[..., span:span + P], ctx_v))

    o = lax.map(block, (jnp.arange(nb), qb))
    return jnp.moveaxis(o, 0, 1).reshape(Bn, L, Hk * G * dh)


def neighborhood_attn_latent(q, k, v, ctx_k, ctx_v, rpb):
    Bn, L, H, dh = q.shape
    rows = L // GRID_W
    kr = min(NA_ROWS, rows)
    n_nb = kr * NA_COLS
    scale = dh ** -0.5
    qg = jnp.moveaxis(q.reshape(Bn, rows, GRID_W, H, dh), 1, 0)
    kg = k.reshape(Bn, rows, GRID_W, H, dh)
    vg = v.reshape(Bn, rows, GRID_W, H, dh)
    col = jnp.arange(GRID_W)
    cstart = jnp.clip(col - NA_COLS // 2, 0, GRID_W - NA_COLS)
    col_idx = cstart[:, None] + jnp.arange(NA_COLS)[None, :]
    dcol = col_idx - col[:, None] + (NA_COLS - 1)
    rpb32 = rpb.astype(F32)

    def row_block(args):
        r, qr = args
        rstart = jnp.clip(r - NA_ROWS // 2, 0, rows - kr)
        kband = lax.dynamic_slice_in_dim(kg, rstart, kr, axis=1)
        vband = lax.dynamic_slice_in_dim(vg, rstart, kr, axis=1)
        kn = kband[:, :, col_idx]
        vn = vband[:, :, col_idx]
        drow = rstart + jnp.arange(kr) - r + (NA_ROWS - 1)
        bias = rpb32[:, drow[None, :, None], dcol[:, None, :]]
        s_nb = jnp.einsum('bwhd,brwjhd->bhwrj', qr, kn, preferred_element_type=F32) * scale + bias[None]
        s_nb = s_nb.reshape(Bn, H, GRID_W, n_nb)
        s_ctx = jnp.einsum('bwhd,bphd->bhwp', qr, ctx_k, preferred_element_type=F32) * scale
        pr = jax.nn.softmax(jnp.concatenate([s_nb, s_ctx], axis=-1), axis=-1).astype(v.dtype)
        p_nb = pr[..., :n_nb].reshape(Bn, H, GRID_W, kr, NA_COLS)
        return (jnp.einsum('bhwrj,brwjhd->bwhd', p_nb, vn)
                + jnp.einsum('bhwp,bphd->bwhd', pr[..., n_nb:], ctx_v))

    o = lax.map(row_block, (jnp.arange(rows), qg))
    return jnp.moveaxis(o, 0, 1).reshape(Bn, L, H * dh)


def hyena_spectrum(L, p):
    t = jnp.arange(L, dtype=F32) / L
    bands = 2.0 * jnp.pi * jnp.arange(1, HYENA_BANDS + 1, dtype=F32)
    ang = t[:, None] * bands[None, :]
    feats = jnp.concatenate([t[:, None], jnp.sin(ang), jnp.cos(ang)], axis=-1)
    freq = p["hy_freq"].astype(F32)
    z = jnp.sin(freq[0] * (feats @ p["hy_w1"].astype(F32) + p["hy_b1"].astype(F32)))
    z = jnp.sin(freq[1] * (z @ p["hy_w2"].astype(F32) + p["hy_b2"].astype(F32)))
    h = (z @ p["hy_w3"].astype(F32)).reshape(L, HYENA_ORDER, 2, B_WIDTH)
    h = h * jnp.exp(-jnp.abs(p["hy_decay"].astype(F32))[None] * t[:, None, None, None])
    fwd, bwd = h[:, :, 0], h[:, :, 1]
    two = jnp.concatenate([fwd, jnp.zeros((1, HYENA_ORDER, B_WIDTH), F32), bwd[:0:-1]], axis=0)
    return jnp.fft.rfft(two, axis=0)


def fft_conv(u, spec, skip):
    L = u.shape[1]
    uf = u.astype(F32)
    y = jnp.fft.irfft(jnp.fft.rfft(uf, n=2 * L, axis=1) * spec[None], n=2 * L, axis=1)[:, :L]
    return (y + uf * skip.astype(F32)).astype(u.dtype)


def short_conv(u, w, b):
    L = u.shape[1]
    half = SHORT_CONV // 2
    up = jnp.pad(u, ((0, 0), (half, SHORT_CONV - 1 - half), (0, 0)))
    y = b
    for j in range(SHORT_CONV):
        y = y + up[:, j:j + L] * w[j]
    return y


def hyena_mix(u, p):
    L = u.shape[1]
    spec = hyena_spectrum(L, p)
    u = short_conv(u, p["hy_conv_w"], p["hy_conv_b"])
    v, x1, x2 = jnp.split(u, 3, axis=-1)
    z = x1 * fft_conv(v, spec[:, 0], p["hy_skip"][0])
    return x2 * fft_conv(z, spec[:, 1], p["hy_skip"][1])


def merge_branches(ya, ag, yb, bg, yc, cg, mg, p):
    ga, gb, gc = jnp.split(mg, N_BRANCH, axis=-1)
    m = (jax.nn.sigmoid(ga) * jnp.matmul(ya * jax.nn.silu(ag), p["w_up_a"])
         + jax.nn.sigmoid(gb) * jnp.matmul(yb * jax.nn.silu(bg), p["w_up_b"])
         + jax.nn.sigmoid(gc) * jnp.matmul(yc * jax.nn.silu(cg), p["w_up_c"]))
    return jnp.matmul(m, p["w_out"])


def context_layer(x, cond, p):
    Bn, S, _ = x.shape
    (aq, ak, av, ag, bu, bg, cqkv, cg, mg), gate = project(x, cond, p)
    aq = aq.reshape(Bn, S, A_KV_HEADS, A_GROUP, HEAD_DIM)
    ak = ak.reshape(Bn, S, A_KV_HEADS, HEAD_DIM)
    av = av.reshape(Bn, S, A_KV_HEADS, HEAD_DIM)
    ya = context_attn(aq, ak, av, p["a_sink"].reshape(A_KV_HEADS, A_GROUP))
    yb = hyena_mix(bu, p)
    cq, ck, cv = jnp.split(cqkv, 3, axis=-1)
    cq = cq.reshape(Bn, S, C_HEADS, 1, HEAD_DIM)
    ck = ck.reshape(Bn, S, C_HEADS, HEAD_DIM)
    cv = cv.reshape(Bn, S, C_HEADS, HEAD_DIM)
    yc = context_attn(cq, ck, cv, None)
    out = merge_branches(ya, ag, yb, bg, yc, cg, mg, p)
    return x + gate * out, ak, av, ck, cv


def latent_layer(x, cond, ctx_ak, ctx_av, ctx_ck, ctx_cv, p):
    Bn, L, _ = x.shape
    (aq, ak, av, ag, bu, bg, cqkv, cg, mg), gate = project(x, cond, p)
    cos, sin = axial_rope(L)
    aq = apply_rope(aq.reshape(Bn, L, A_HEADS, HEAD_DIM), cos, sin).reshape(Bn, L, A_KV_HEADS, A_GROUP, HEAD_DIM)
    ak = apply_rope(ak.reshape(Bn, L, A_KV_HEADS, HEAD_DIM), cos, sin)
    av = av.reshape(Bn, L, A_KV_HEADS, HEAD_DIM)
    ya = window_attn_latent(aq, ak, av, ctx_ak, ctx_av, p["a_sink"].reshape(A_KV_HEADS, A_GROUP))
    yb = hyena_mix(bu, p)
    cq, ck, cv = jnp.split(cqkv, 3, axis=-1)
    cq = cq.reshape(Bn, L, C_HEADS, HEAD_DIM)
    ck = ck.reshape(Bn, L, C_HEADS, HEAD_DIM)
    cv = cv.reshape(Bn, L, C_HEADS, HEAD_DIM)
    yc = neighborhood_attn_latent(cq, ck, cv, ctx_ck, ctx_cv, p["c_rpb"])
    out = merge_branches(ya, ag, yb, bg, yc, cg, mg, p)
    return x + gate * out


def setup_inputs(seed: int = 0) -> dict:
    key = jax.random.key(seed)
    ks = jax.random.split(key, 32)

    def nrm(k, shape, s):
        return s * jax.random.normal(k, shape, F32)

    return {
        "x_prompt": nrm(ks[0], (BATCH, SEQ, D_MODEL), 1.0),
        "x_sample": nrm(ks[1], (DEC_BATCH, DEC_SEQ, D_MODEL), 1.0),
        "c": nrm(ks[2], (DEC_BATCH, D_MODEL), 1.0),
        "cache_a_k": nrm(ks[3], (DEC_BATCH, DEPTH, PAST_LEN, A_KV_HEADS, HEAD_DIM), 1.0),
        "cache_a_v": nrm(ks[4], (DEC_BATCH, DEPTH, PAST_LEN, A_KV_HEADS, HEAD_DIM), 1.0),
        "cache_c_k": nrm(ks[5], (DEC_BATCH, DEPTH, PAST_LEN, C_HEADS, HEAD_DIM), 1.0),
        "cache_c_v": nrm(ks[6], (DEC_BATCH, DEPTH, PAST_LEN, C_HEADS, HEAD_DIM), 1.0),
        "c_ctx": nrm(ks[7], (D_MODEL,), 1.0),
        "norm_w": 1.0 + nrm(ks[8], (DEPTH, D_MODEL), 0.01),
        "w_ada": nrm(ks[9], (DEPTH, D_MODEL, 3 * D_MODEL), 0.5 * D_MODEL ** -0.5),
        "b_ada": nrm(ks[10], (DEPTH, 3 * D_MODEL), 0.1),
        "w_in": nrm(ks[11], (DEPTH, D_MODEL, IN_WIDTH), D_MODEL ** -0.5),
        "a_sink": nrm(ks[12], (DEPTH, A_HEADS), 1.0),
        "hy_conv_w": nrm(ks[13], (DEPTH, SHORT_CONV, 3 * B_WIDTH), SHORT_CONV ** -0.5),
        "hy_conv_b": nrm(ks[14], (DEPTH, 3 * B_WIDTH), 0.02),
        "hy_w1": nrm(ks[15], (DEPTH, HYENA_EMB, HYENA_HIDDEN), HYENA_EMB ** -0.5),
        "hy_b1": nrm(ks[16], (DEPTH, HYENA_HIDDEN), 0.1),
        "hy_w2": nrm(ks[17], (DEPTH, HYENA_HIDDEN, HYENA_HIDDEN), HYENA_HIDDEN ** -0.5),
        "hy_b2": nrm(ks[18], (DEPTH, HYENA_HIDDEN), 0.1),
        "hy_freq": 1.0 + nrm(ks[19], (DEPTH, 2, HYENA_HIDDEN), 0.1),
        "hy_w3": nrm(ks[20], (DEPTH, HYENA_HIDDEN, HYENA_ORDER * 2 * B_WIDTH), 0.05 * HYENA_HIDDEN ** -0.5),
        "hy_decay": jax.random.uniform(ks[21], (DEPTH, HYENA_ORDER, 2, B_WIDTH), F32, 3.0, 15.0),
        "hy_skip": 1.0 + nrm(ks[22], (DEPTH, HYENA_ORDER, B_WIDTH), 0.1),
        "c_rpb": nrm(ks[23], (DEPTH, C_HEADS, 2 * NA_ROWS - 1, 2 * NA_COLS - 1), 0.1),
        "w_up_a": nrm(ks[24], (DEPTH, A_WIDTH, D_MODEL), A_WIDTH ** -0.5),
        "w_up_b": nrm(ks[25], (DEPTH, B_WIDTH, D_MODEL), B_WIDTH ** -0.5),
        "w_up_c": nrm(ks[26], (DEPTH, C_WIDTH, D_MODEL), C_WIDTH ** -0.5),
        "w_out": nrm(ks[27], (DEPTH, D_MODEL, D_MODEL), D_MODEL ** -0.5),
        "final_norm_w": 1.0 + nrm(ks[28], (D_MODEL,), 0.01),
    }


def reference(x_prompt, x_sample, c, cache_a_k, cache_a_v, cache_c_k, cache_c_v, c_ctx,
              norm_w, w_ada, b_ada, w_in, a_sink, hy_conv_w, hy_conv_b, hy_w1, hy_b1, hy_w2, hy_b2,
              hy_freq, hy_w3, hy_decay, hy_skip, c_rpb, w_up_a, w_up_b, w_up_c, w_out, final_norm_w):
    def layer_params(l):
        return {
            "norm_w": norm_w[l], "w_ada": w_ada[l], "b_ada": b_ada[l], "w_in": w_in[l],
            "a_sink": a_sink[l], "hy_conv_w": hy_conv_w[l], "hy_conv_b": hy_conv_b[l],
            "hy_w1": hy_w1[l], "hy_b1": hy_b1[l], "hy_w2": hy_w2[l], "hy_b2": hy_b2[l],
            "hy_freq": hy_freq[l], "hy_w3": hy_w3[l], "hy_decay": hy_decay[l], "hy_skip": hy_skip[l],
            "c_rpb": c_rpb[l], "w_up_a": w_up_a[l], "w_up_b": w_up_b[l], "w_up_c": w_up_c[l],
            "w_out": w_out[l],
        }

    cond_ctx = c_ctx[None, None, :]
    xp = x_prompt
    aks, avs, cks, cvs = [], [], [], []
    for l in range(DEPTH):
        xp, ak, av, ck, cv = context_layer(xp, cond_ctx, layer_params(l))
        aks.append(ak)
        avs.append(av)
        cks.append(ck)
        cvs.append(cv)
    y_prompt = rms_norm(xp, final_norm_w)
    new_a_k = jnp.stack(aks, axis=1)
    new_a_v = jnp.stack(avs, axis=1)
    new_c_k = jnp.stack(cks, axis=1)
    new_c_v = jnp.stack(cvs, axis=1)

    cond_lat = c[:, None, :]
    xs = x_sample
    for l in range(DEPTH):
        xs = latent_layer(xs, cond_lat, cache_a_k[:, l], cache_a_v[:, l], cache_c_k[:, l], cache_c_v[:, l],
                          layer_params(l))
    y_sample = rms_norm(xs, final_norm_w)

    return (y_prompt, y_sample, new_a_k, new_a_v, new_c_k, new_c_v)
```

```cpp
#include <hip/hip_runtime.h>
#include <hip/hip_cooperative_groups.h>
#include <cstdio>
#include <cstdint>
namespace cg = cooperative_groups;

#define LAS __attribute__((address_space(3)))
typedef unsigned short bf16_t;
typedef short bf16x8 __attribute__((ext_vector_type(8)));
typedef float f32x4 __attribute__((ext_vector_type(4)));
typedef unsigned u32x4 __attribute__((ext_vector_type(4)));
typedef unsigned u32x2 __attribute__((ext_vector_type(2)));

constexpr int D = 2048, NCTXTOK = 8192, LLAT = 4096, LCTX = 256, PAST = 512;
constexpr int INW = 13312, U7W = 7168, MGW = 6144;
constexpr int NTHREADS = 512;
constexpr int LDS_BYTES = 131072;
constexpr size_t OUT_AK = 83886080ull, OUT_AV = 88080384ull, OUT_CK = 92274688ull, OUT_CV = 104857600ull;
constexpr size_t OFF_MOD = 4096;
constexpr size_t OFF_ROPE = OFF_MOD + 2ull * 9 * 6144 * 4;
constexpr size_t OFF_Z2 = OFF_ROPE + 8192;
constexpr size_t OFF_WTIN = OFF_Z2 + 2ull * 4352 * 64 * 4;
constexpr size_t OFF_WTUP = OFF_WTIN + 13312ull * 2048 * 2;
constexpr size_t OFF_WTOUT = OFF_WTUP + 2048ull * 2048 * 2;
constexpr size_t OFF_SPECL = OFF_WTOUT + 2048ull * 2048 * 2;
constexpr size_t OFF_SPECS = OFF_SPECL + 2ull * 512 * 8192 * 8;
constexpr size_t OFF_H = OFF_SPECS + 2ull * 512 * 512 * 8;
constexpr size_t OFF_U7 = OFF_H + 24576ull * 2048 * 2;
constexpr size_t OFF_MG = OFF_U7 + 24576ull * 7168 * 2;
constexpr size_t WS_END = OFF_MG + 24576ull * 6144 * 2;

struct Params { const float* in[29]; float* out; unsigned char* ws; };
enum { I_XP = 0, I_XS, I_C, I_CAK, I_CAV, I_CCK, I_CCV, I_CCTX, I_NW, I_WADA, I_BADA, I_WIN, I_SINK, I_HCW, I_HCB, I_HW1, I_HB1, I_HW2, I_HB2,
       I_HFREQ, I_HW3, I_HDEC, I_HSKIP, I_RPB, I_WUA, I_WUB, I_WUC, I_WOUT, I_FNW };

struct Chunk { int tok0, ntok, nctxb, lat_row0, latb0, nlatb; };
__device__ __forceinline__ Chunk get_chunk(int c) { Chunk k; if (c == 0) { k.tok0 = 0; k.ntok = 24576; k.nctxb = 32; k.lat_row0 = 8192; k.latb0 = 0; k.nlatb = 4; } else { k.tok0 = 24576; k.ntok = 16384; k.nctxb = 0; k.lat_row0 = 0; k.latb0 = 4; k.nlatb = 4; } return k; }
__device__ __forceinline__ int cond_of(int g) { return g < NCTXTOK ? 0 : 1 + ((g - NCTXTOK) >> 12); }

__device__ __forceinline__ unsigned cvt_pk_bf16(float lo, float hi) { unsigned r; asm volatile("v_cvt_pk_bf16_f32 %0, %1, %2" : "=v"(r) : "v"(lo), "v"(hi)); return r; }
__device__ __forceinline__ float bf_lo(unsigned u) { return __uint_as_float(u << 16); }
__device__ __forceinline__ float bf_hi(unsigned u) { return __uint_as_float(u & 0xffff0000u); }
__device__ __forceinline__ float bf2f(bf16_t b) { return __uint_as_float(((unsigned)b) << 16); }
__device__ __forceinline__ bf16_t f2bf(float f) { return (bf16_t)(cvt_pk_bf16(f, 0.f) & 0xffffu); }
__device__ __forceinline__ float wave_sum(float v) {
#pragma unroll
    for (int o = 1; o < 64; o <<= 1) v += __shfl_xor(v, o);
    return v;
}
__device__ __forceinline__ float sigmoidf_(float x) { return 1.f / (1.f + __expf(-x)); }

constexpr int BM = 256, BK = 64, HALF = 128, HTB = HALF * BK * 2;
__device__ __forceinline__ int lds_byte(int r, int c) { const int st = (r >> 4) * 2 + (c >> 5), rr = r & 15, cc = c & 31, ob = rr * 64 + cc * 2; return st * 1024 + (ob ^ (((ob >> 9) & 1) << 5)); }
__device__ __forceinline__ void stage_rc(int b, int& R, int& C) { const int st = b / 1024, sb = b % 1024, swz = sb ^ (((sb >> 9) & 1) << 5); R = (st >> 1) * 16 + swz / 64; C = (st & 1) * 32 + (swz % 64) / 2; }
__device__ __forceinline__ int perm32(int rho) { const int n = rho >> 4, i = rho & 15; return 8 * (i >> 2) + 4 * n + (i & 3); }

struct GSched { int nM, nN, ntile, G, c; };
template <int PER>
__device__ __forceinline__ bool gs_next(const GSched& S, int ui, int& pm, int& pn, int& br) {
    const int round = ui / PER; br = ui - round * PER;
    const long L = (long)round * S.G + S.c; if (L >= S.ntile) return false;
    int wgid = (int)L; { const int q = S.ntile / 8, r = S.ntile % 8, xcd = wgid % 8, off = wgid / 8; wgid = (xcd < r ? xcd * (q + 1) : r * (q + 1) + (xcd - r) * q) + off; }
    const int nig = 8 * S.nN, gid = wgid / nig, fm = gid * 8, gsz = (S.nM - fm) < 8 ? (S.nM - fm) : 8;
    pm = fm + ((wgid % nig) % gsz); pn = (wgid % nig) / gsz; return true;
}

template <int MODE>
__device__ __forceinline__ void gemm_phase(LAS unsigned char* lds, const Params& P, const int layer, const Chunk ck) {
    constexpr bool PERM = (MODE != 5);
    constexpr int PER = (MODE == 4) ? 3 : 1;
    int tid_ = threadIdx.x; asm volatile("" : "+v"(tid_));
    const int tid = tid_, wid = __builtin_amdgcn_readfirstlane(tid >> 6), lane = tid & 63, wr = wid >> 2, wc = wid & 3, fr = lane & 15, fq = lane >> 4;
    const char* Abase; const char* Bbase; unsigned lda, ldb; int nN;
    if (MODE == 2) { Abase = (const char*)(P.ws + OFF_H); lda = 4096u; Bbase = (const char*)(P.ws + OFF_WTIN); ldb = 4096u; nN = 52; }
    else if (MODE == 4) { Abase = (const char*)(P.ws + OFF_U7); lda = 14336u; Bbase = (const char*)(P.ws + OFF_WTUP); ldb = 4096u; nN = 8; }
    else { Abase = (const char*)(P.ws + OFF_H); lda = 4096u; Bbase = (const char*)(P.ws + OFF_WTOUT); ldb = 4096u; nN = 8; }
    GSched S; S.nM = ck.ntok / 256; S.nN = nN; S.ntile = S.nM * nN; S.G = (int)gridDim.x; S.c = (int)blockIdx.x;
    unsigned voffA[2], voffB[2];
#pragma unroll
    for (int i = 0; i < 2; ++i) { int R, C; stage_rc(tid * 16 + i * 8192, R, C); const int Rb = PERM ? ((R & ~31) + perm32(R & 31)) : R;
        voffA[i] = (unsigned)R * lda + (unsigned)C * 2u; voffB[i] = (unsigned)Rb * ldb + (unsigned)C * 2u; }
    const size_t kstep = (size_t)(BK * 2);
    const size_t hstepA = (size_t)HALF * lda, hstepB = (size_t)HALF * ldb;
    const unsigned ldsw = (unsigned)wid * 1024u;
    const int aoff = lds_byte(wr * 64 + fr, fq * 8), boff = lds_byte(wc * 32 + fr, fq * 8);
#define PG8_SA(b, h) (((b) * 2 + (h)) * HTB)
#define PG8_SB(b, h) ((4 + (b) * 2 + (h)) * HTB)
#define PG8_STAGE(bufoff, gbase, voff) do { _Pragma("unroll") for (int _i = 0; _i < 2; ++_i) \
        __builtin_amdgcn_global_load_lds((const unsigned*)((const char*)(gbase) + (voff)[_i]), (LAS unsigned*)(lds + (bufoff) + ldsw + _i * 8192), 16, 0, 0); } while (0)
#define PG8_LDA(dst, b, h) do { _Pragma("unroll") for (int m = 0; m < 4; ++m) _Pragma("unroll") for (int k = 0; k < 2; ++k) dst[m][k] = *(const LAS bf16x8*)(lds + PG8_SA(b, h) + aoff + m * 2048 + k * 1024); } while (0)
#define PG8_LDB(dst, b, h) do { _Pragma("unroll") for (int n = 0; n < 2; ++n) _Pragma("unroll") for (int k = 0; k < 2; ++k) dst[n][k] = *(const LAS bf16x8*)(lds + PG8_SB(b, h) + boff + n * 2048 + k * 1024); } while (0)
#define PG8_MMA(ai, bj, At, Bt) do { __builtin_amdgcn_s_setprio(1); _Pragma("unroll") for (int m = 0; m < 4; ++m) _Pragma("unroll") for (int n = 0; n < 2; ++n) _Pragma("unroll") for (int k = 0; k < 2; ++k) \
        acc[ai][bj][m][n] = __builtin_amdgcn_mfma_f32_16x16x32_bf16(Bt[n][k], At[m][k], acc[ai][bj][m][n], 0, 0, 0); __builtin_amdgcn_s_setprio(0); } while (0)
#define PG8_WAIT_V(n) asm volatile("s_waitcnt vmcnt(" #n ")" ::: "memory")
#define PG8_WAIT_L(n) asm volatile("s_waitcnt lgkmcnt(" #n ")" ::: "memory")
#define PG8_BAR __builtin_amdgcn_s_barrier()
#define PG8_SCHED __builtin_amdgcn_sched_barrier(0)
#define UNIT_PTRS(pm_, pn_, br_, a_, b_, nt_) do { \
        if (MODE == 4) { const int acol = (br_) == 0 ? 1280 : ((br_) == 1 ? 3584 : 6400), bk = (br_) == 0 ? 0 : ((br_) == 1 ? 768 : 1280); nt_ = (br_) == 1 ? 8 : 12; \
            a_ = Abase + (size_t)(pm_) * 256 * lda + (size_t)acol * 2; b_ = Bbase + (size_t)(pn_) * 256 * ldb + (size_t)bk * 2; } \
        else { nt_ = 32; a_ = Abase + (size_t)(pm_) * 256 * lda; b_ = Bbase + (size_t)(pn_) * 256 * ldb; } } while (0)
    int pm, pn, br, npm, npn, nbr; int ui = 0;
    if (!gs_next<PER>(S, 0, pm, pn, br)) return;
    f32x4 acc[2][2][4][2];
#pragma unroll
    for (int a = 0; a < 2; ++a)
#pragma unroll
        for (int b = 0; b < 2; ++b)
#pragma unroll
            for (int m = 0; m < 4; ++m)
#pragma unroll
                for (int n = 0; n < 2; ++n) acc[a][b][m][n] = (f32x4){0.f, 0.f, 0.f, 0.f};
    bf16x8 At[4][2], B0[2][2], B1[2][2];
    const char* cA; const char* cB; int nt;
    UNIT_PTRS(pm, pn, br, cA, cB, nt);
    PG8_STAGE(PG8_SB(0, 0), cB, voffB); PG8_STAGE(PG8_SB(0, 1), cB + hstepB, voffB); PG8_STAGE(PG8_SA(0, 0), cA, voffA); PG8_STAGE(PG8_SA(0, 1), cA + hstepA, voffA);
    if (wr == 1) PG8_BAR;
    PG8_WAIT_V(2); PG8_BAR;
    PG8_STAGE(PG8_SB(1, 0), cB + kstep, voffB); PG8_STAGE(PG8_SA(1, 0), cA + kstep, voffA); PG8_STAGE(PG8_SB(1, 1), cB + hstepB + kstep, voffB);
    PG8_WAIT_V(6); PG8_BAR;
    for (;;) {
        const bool has_next = gs_next<PER>(S, ui + 1, npm, npn, nbr);
        const char* nA = cA; const char* nB = cB; int nnt = nt;
        if (has_next) { UNIT_PTRS(npm, npn, nbr, nA, nB, nnt); }
        for (int t = 0; t < nt; t += 2) {
            const bool last = (t == nt - 2);
            const char* a1 = cA + (size_t)(t + 1) * kstep;
            const char* a2 = last ? nA : cA + (size_t)(t + 2) * kstep; const char* b2 = last ? nB : cB + (size_t)(t + 2) * kstep;
            const char* a3 = a2 + kstep; const char* b3 = b2 + kstep;
            PG8_LDB(B0, 0, 0); PG8_LDB(B1, 0, 1); PG8_SCHED; PG8_LDA(At, 0, 0); PG8_STAGE(PG8_SA(1, 1), a1 + hstepA, voffA);
            PG8_WAIT_V(8); PG8_WAIT_L(0); PG8_BAR; PG8_MMA(0, 0, At, B0); PG8_MMA(0, 1, At, B1); PG8_BAR; PG8_SCHED;
            PG8_LDA(At, 0, 1); PG8_STAGE(PG8_SB(0, 0), b2, voffB); PG8_STAGE(PG8_SB(0, 1), b2 + hstepB, voffB); PG8_STAGE(PG8_SA(0, 0), a2, voffA);
            PG8_WAIT_V(8); PG8_WAIT_L(0); PG8_BAR; PG8_MMA(1, 0, At, B0); PG8_MMA(1, 1, At, B1); PG8_BAR; PG8_SCHED;
            PG8_LDB(B0, 1, 0); PG8_LDB(B1, 1, 1); PG8_SCHED; PG8_LDA(At, 1, 0); PG8_STAGE(PG8_SA(0, 1), a2 + hstepA, voffA);
            PG8_WAIT_V(8); PG8_WAIT_L(0); PG8_BAR; PG8_MMA(0, 0, At, B0); PG8_MMA(0, 1, At, B1); PG8_BAR; PG8_SCHED;
            PG8_LDA(At, 1, 1); PG8_STAGE(PG8_SB(1, 0), b3, voffB); PG8_STAGE(PG8_SB(1, 1), b3 + hstepB, voffB); PG8_STAGE(PG8_SA(1, 0), a3, voffA);
            PG8_WAIT_V(8); PG8_WAIT_L(0); PG8_BAR; PG8_MMA(1, 0, At, B0); PG8_MMA(1, 1, At, B1); PG8_BAR; PG8_SCHED;
        }
        if (wr == 0) PG8_BAR;
        {
            const int row0 = pm * BM + wr * 64 + fr;
            if (MODE == 2) {
                const int colt = pn * BM + wc * 32 + 8 * fq;
                const bool isu = pn < 28;
                bf16_t* dst = isu ? (bf16_t*)(P.ws + OFF_U7) + colt : (bf16_t*)(P.ws + OFF_MG) + (colt - U7W);
                const int ldd = isu ? U7W : MGW;
                float* kvo = nullptr; int kvw = 0, kvc = 0;
                if (ck.tok0 + pm * BM < NCTXTOK) {
                    if (pn == 3) { kvo = P.out + OUT_AK; kvw = 256; kvc = colt - 768; }
                    else if (pn == 4) { kvo = P.out + OUT_AV; kvw = 256; kvc = colt - 1024; }
                    else if (pn >= 19 && pn < 22) { kvo = P.out + OUT_CK; kvw = 768; kvc = colt - 4864; }
                    else if (pn >= 22 && pn < 25) { kvo = P.out + OUT_CV; kvw = 768; kvc = colt - 5632; }
                }
#pragma unroll
                for (int ai = 0; ai < 2; ++ai)
#pragma unroll
                    for (int m = 0; m < 4; ++m) {
                        const int r = row0 + ai * HALF + m * 16;
#pragma unroll
                        for (int bj = 0; bj < 2; ++bj) {
                            const f32x4 v0 = acc[ai][bj][m][0], v1 = acc[ai][bj][m][1];
                            u32x4 w; w.x = cvt_pk_bf16(v0[0], v0[1]); w.y = cvt_pk_bf16(v0[2], v0[3]); w.z = cvt_pk_bf16(v1[0], v1[1]); w.w = cvt_pk_bf16(v1[2], v1[3]);
                            *(u32x4*)(dst + (size_t)r * ldd + bj * HALF) = w;
                            if (kvo) { const int g = ck.tok0 + r; const int bb = g >> 8, s = g & 255;
                                float* o = kvo + ((size_t)(bb * 2 + layer) * 256 + s) * kvw + kvc + bj * HALF;
                                *(f32x4*)o = v0; *(f32x4*)(o + 4) = v1; }
                        }
                    }
            } else if (MODE == 4) {
                const int colt = pn * BM + wc * 32 + 8 * fq;
                const bf16_t* mg = (const bf16_t*)(P.ws + OFF_MG);
                bf16_t* mo = (bf16_t*)(P.ws + OFF_H);
#pragma unroll
                for (int ai = 0; ai < 2; ++ai)
#pragma unroll
                    for (int m = 0; m < 4; ++m) {
                        const int r = row0 + ai * HALF + m * 16;
#pragma unroll
                        for (int bj = 0; bj < 2; ++bj) {
                            const int c0 = colt + bj * HALF;
                            const bf16_t* mr = mg + (size_t)r * MGW + c0;
                            float f[8];
                            if (br == 0) { const u32x4 ga = *(const u32x4*)mr, gb = *(const u32x4*)(mr + 2048);
#pragma unroll
                                for (int e = 0; e < 4; ++e) { f[2 * e] = (1.f + __expf(-bf_lo(gb[e]))) / (1.f + __expf(-bf_lo(ga[e]))); f[2 * e + 1] = (1.f + __expf(-bf_hi(gb[e]))) / (1.f + __expf(-bf_hi(ga[e]))); } }
                            else if (br == 1) { const u32x4 ga = *(const u32x4*)(mr + 2048), gb = *(const u32x4*)(mr + 4096);
#pragma unroll
                                for (int e = 0; e < 4; ++e) { f[2 * e] = (1.f + __expf(-bf_lo(gb[e]))) / (1.f + __expf(-bf_lo(ga[e]))); f[2 * e + 1] = (1.f + __expf(-bf_hi(gb[e]))) / (1.f + __expf(-bf_hi(ga[e]))); } }
                            else { const u32x4 ga = *(const u32x4*)(mr + 4096);
#pragma unroll
                                for (int e = 0; e < 4; ++e) { f[2 * e] = 1.f / (1.f + __expf(-bf_lo(ga[e]))); f[2 * e + 1] = 1.f / (1.f + __expf(-bf_hi(ga[e]))); } }
                            f32x4 v0 = acc[ai][bj][m][0], v1 = acc[ai][bj][m][1];
                            v0[0] *= f[0]; v0[1] *= f[1]; v0[2] *= f[2]; v0[3] *= f[3]; v1[0] *= f[4]; v1[1] *= f[5]; v1[2] *= f[6]; v1[3] *= f[7];
                            if (br == 2) { u32x4 w; w.x = cvt_pk_bf16(v0[0], v0[1]); w.y = cvt_pk_bf16(v0[2], v0[3]); w.z = cvt_pk_bf16(v1[0], v1[1]); w.w = cvt_pk_bf16(v1[2], v1[3]);
                                *(u32x4*)(mo + (size_t)r * D + c0) = w; v0 = (f32x4){0.f, 0.f, 0.f, 0.f}; v1 = v0; }
                            acc[ai][bj][m][0] = v0; acc[ai][bj][m][1] = v1;
                        }
                    }
            } else {
                const int colt = pn * BM + wc * 32 + 4 * fq;
#pragma unroll
                for (int ai = 0; ai < 2; ++ai)
#pragma unroll
                    for (int m = 0; m < 4; ++m) {
                        const int r = row0 + ai * HALF + m * 16; const int g = ck.tok0 + r;
                        const float* xo = (layer == 0) ? (g < NCTXTOK ? P.in[I_XP] + (size_t)g * D : P.in[I_XS] + (size_t)(g - NCTXTOK) * D) : P.out + (size_t)g * D;
                        float* yo = P.out + (size_t)g * D;
                        const float* gt = (const float*)(P.ws + OFF_MOD) + ((size_t)layer * 9 + cond_of(g)) * 6144 + 4096;
#pragma unroll
                        for (int bj = 0; bj < 2; ++bj)
#pragma unroll
                            for (int n = 0; n < 2; ++n) { const int c = colt + bj * HALF + n * 16;
                                const f32x4 xv = *(const f32x4*)(xo + c), gv = *(const f32x4*)(gt + c);
                                *(f32x4*)(yo + c) = xv + gv * acc[ai][bj][m][n]; }
                    }
            }
        }
        if (!has_next) break;
        if (MODE != 4) {
#pragma unroll
            for (int a = 0; a < 2; ++a)
#pragma unroll
                for (int b = 0; b < 2; ++b)
#pragma unroll
                    for (int m = 0; m < 4; ++m)
#pragma unroll
                        for (int n = 0; n < 2; ++n) acc[a][b][m][n] = (f32x4){0.f, 0.f, 0.f, 0.f};
        }
        pm = npm; pn = npn; br = nbr; cA = nA; cB = nB; nt = nnt; ++ui;
        if (wr == 1) PG8_BAR;
    }
    PG8_WAIT_V(0);
    PG8_BAR;
#undef PG8_SA
#undef PG8_SB
#undef PG8_STAGE
#undef PG8_LDA
#undef PG8_LDB
#undef PG8_MMA
#undef PG8_WAIT_V
#undef PG8_WAIT_L
#undef PG8_BAR
#undef PG8_SCHED
#undef UNIT_PTRS
}

__device__ __forceinline__ void fft_fwd(float2* d, const float2* tw, int mfirst, int tid) {
    for (int m = mfirst; m >= 1; m >>= 1) {
        __syncthreads();
        const int sh = 4096 / m;
#pragma unroll
        for (int r = 0; r < 8; ++r) { const int q = tid + 512 * r, j = q & (m - 1), i = 2 * q - j;
            const float2 a = d[i], b = d[i + m], w = tw[j * sh];
            d[i] = make_float2(a.x + b.x, a.y + b.y); const float tx = a.x - b.x, ty = a.y - b.y;
            d[i + m] = make_float2(tx * w.x - ty * w.y, tx * w.y + ty * w.x); }
    }
    __syncthreads();
}
__device__ __forceinline__ void fft_inv(float2* d, const float2* tw, int mfirst, int tid) {
    for (int m = 1; m <= mfirst; m <<= 1) {
        __syncthreads();
        const int sh = 4096 / m;
#pragma unroll
        for (int r = 0; r < 8; ++r) { const int q = tid + 512 * r, j = q & (m - 1), i = 2 * q - j;
            const float2 a = d[i], b0 = d[i + m], w = tw[j * sh];
            const float bx = b0.x * w.x + b0.y * w.y, by = b0.y * w.x - b0.x * w.y;
            d[i] = make_float2(a.x + bx, a.y + by); d[i + m] = make_float2(a.x - bx, a.y - by); }
    }
    __syncthreads();
}
__device__ __forceinline__ void fft_init_tw(float2* tw, int tid) {
    for (int k = tid; k < 4096; k += NTHREADS) { float s, c; sincospif((float)k * (1.f / 4096.f), &s, &c); tw[k] = make_float2(c, -s); }
    __syncthreads();
}

__device__ __forceinline__ void phase0(const Params& P, unsigned char* smem) {
    int tid_ = threadIdx.x; asm volatile("" : "+v"(tid_));
    const int tid = tid_, lane = tid & 63, wave = tid >> 6;
    for (int it = blockIdx.x; it < 192 + 1 + 136; it += gridDim.x) {
        __syncthreads();
        if (it < 192) {
            const int l = it / 96, col0 = (it % 96) * 64;
            float* s = (float*)smem; float* red = (float*)(smem + 9 * 2048 * 4);
            for (int i = tid; i < 9 * 2048; i += NTHREADS) { const int v = i >> 11, k = i & 2047; const float x = (v == 0) ? P.in[I_CCTX][k] : P.in[I_C][(v - 1) * 2048 + k]; s[i] = x / (1.f + expf(-x)); }
            __syncthreads();
            const int kg = tid >> 4, cj = tid & 15;
            float acc[9][4];
#pragma unroll
            for (int v = 0; v < 9; ++v) { acc[v][0] = 0.f; acc[v][1] = 0.f; acc[v][2] = 0.f; acc[v][3] = 0.f; }
            const float* wp = P.in[I_WADA] + (size_t)l * 2048 * 6144 + col0 + 4 * cj;
#pragma unroll 4
            for (int k = kg; k < 2048; k += 32) { const f32x4 w = *(const f32x4*)(wp + (size_t)k * 6144);
#pragma unroll
                for (int v = 0; v < 9; ++v) { const float sv = s[v * 2048 + k]; acc[v][0] += sv * w[0]; acc[v][1] += sv * w[1]; acc[v][2] += sv * w[2]; acc[v][3] += sv * w[3]; } }
#pragma unroll
            for (int v = 0; v < 9; ++v)
#pragma unroll
                for (int e = 0; e < 4; ++e) { float a = acc[v][e]; a += __shfl_xor(a, 16); a += __shfl_xor(a, 32); acc[v][e] = a; }
            if (lane < 16) {
#pragma unroll
                for (int v = 0; v < 9; ++v)
#pragma unroll
                    for (int e = 0; e < 4; ++e) red[(wave * 16 + cj) * 36 + v * 4 + e] = acc[v][e];
            }
            __syncthreads();
            for (int i = tid; i < 9 * 64; i += NTHREADS) { const int v = i >> 6, cc = i & 63; float a = P.in[I_BADA][l * 6144 + col0 + cc];
                for (int w = 0; w < 8; ++w) a += red[(w * 16 + (cc >> 2)) * 36 + v * 4 + (cc & 3)];
                ((float*)(P.ws + OFF_MOD))[((size_t)l * 9 + v) * 6144 + col0 + cc] = a; }
        } else if (it == 192) {
            float2* tab = (float2*)(P.ws + OFF_ROPE);
            for (int i = tid; i < 1024; i += NTHREADS) { const int pos = i >> 4, f = i & 15; const float inv = powf(10000.f, -(float)f / 16.f); const float ang = (float)pos * inv; tab[i] = make_float2(cosf(ang), sinf(ang)); }
        } else {
            const int j = it - 193, l = j / 68, tb = j % 68;
            const bool lng = tb < 64; const int t0 = lng ? tb * 64 : (tb - 64) * 64; const float invL = lng ? (1.f / 4096.f) : (1.f / 256.f);
            const int rowoff = l * 4352 + (lng ? 0 : 4096) + t0;
            float* feats = (float*)smem; float* z1 = feats + 64 * 33;
            for (int i = tid; i < 64 * 33; i += NTHREADS) { const int tl = i / 33, f = i % 33; const float t = (float)(t0 + tl) * invL;
                float v; if (f == 0) v = t; else if (f <= 16) v = sinpif(2.f * (float)f * t); else v = cospif(2.f * (float)(f - 16) * t); feats[i] = v; }
            __syncthreads();
            const int tl = tid >> 3, part = tid & 7;
            const float* w1 = P.in[I_HW1] + (size_t)l * 33 * 64; const float* b1 = P.in[I_HB1] + l * 64; const float* fr0 = P.in[I_HFREQ] + l * 128;
            for (int jj = 0; jj < 8; ++jj) { const int jo = part * 8 + jj; float a = b1[jo];
                for (int f = 0; f < 33; ++f) a += feats[tl * 33 + f] * w1[f * 64 + jo];
                z1[tl * 65 + jo] = sinf(fr0[jo] * a); }
            __syncthreads();
            const float* w2 = P.in[I_HW2] + (size_t)l * 64 * 64; const float* b2 = P.in[I_HB2] + l * 64; const float* fr1 = fr0 + 64;
            float* z2 = (float*)(P.ws + OFF_Z2);
            for (int jj = 0; jj < 8; ++jj) { const int jo = part * 8 + jj; float a = b2[jo];
                for (int f = 0; f < 64; ++f) a += z1[tl * 65 + f] * w2[f * 64 + jo];
                z2[(size_t)(rowoff + tl) * 64 + jo] = sinf(fr1[jo] * a); }
        }
    }
}

__device__ __forceinline__ void transpose_item(const float* W, int N, bf16_t* WT, int koff, int item, float* s, int tid) {
    const int nb = N / 128, kb = item / nb, nbk = item % nb, k0 = kb * 64, n0 = nbk * 128;
#pragma unroll
    for (int i = 0; i < 4; ++i) { const int kk = i * 16 + (tid >> 5), c4 = tid & 31; const f32x4 w = *(const f32x4*)(W + (size_t)(k0 + kk) * N + n0 + 4 * c4);
        float* d = s + kk * 129 + 4 * c4; d[0] = w[0]; d[1] = w[1]; d[2] = w[2]; d[3] = w[3]; }
    __syncthreads();
#pragma unroll
    for (int j = 0; j < 2; ++j) { const int n = (tid >> 3) + 64 * j, c8 = tid & 7; const float* q = s + (8 * c8) * 129 + n;
        u32x4 o; o.x = cvt_pk_bf16(q[0], q[129]); o.y = cvt_pk_bf16(q[2 * 129], q[3 * 129]); o.z = cvt_pk_bf16(q[4 * 129], q[5 * 129]); o.w = cvt_pk_bf16(q[6 * 129], q[7 * 129]);
        *(u32x4*)(WT + (size_t)(n0 + n) * 2048 + koff + k0 + 8 * c8) = o; }
    __syncthreads();
}

__device__ __forceinline__ void phase1(const Params& P, unsigned char* smem, const int layer, const int cidx, const Chunk ck) {
    int tid_ = threadIdx.x; asm volatile("" : "+v"(tid_));
    const int tid = tid_, lane = tid & 63, wave = tid >> 6;
    if (cidx == 0) {
        float2* data = (float2*)smem; float2* tw = (float2*)(smem + 65536); float* w3s = (float*)(smem + 98304);
        fft_init_tw(tw, tid);
        const float* z2 = (const float*)(P.ws + OFF_Z2) + (size_t)layer * 4352 * 64;
        const float* w3 = P.in[I_HW3] + (size_t)layer * 64 * 2048;
        const float* dec = P.in[I_HDEC] + layer * 2048;
        const float* skp = P.in[I_HSKIP] + layer * 1024;
        for (int it = blockIdx.x; it < 1024; it += gridDim.x) {
            const int o = it >> 9, c = it & 511;
            __syncthreads();
            if (tid < 128) { const int d = tid >> 6, j = tid & 63; w3s[tid] = w3[j * 2048 + o * 1024 + d * 512 + c]; }
            __syncthreads();
            const float df = fabsf(dec[o * 1024 + c]), db = fabsf(dec[o * 1024 + 512 + c]), sk = skp[o * 512 + c];
#pragma unroll 1
            for (int i = 0; i < 8; ++i) { const int t = tid + 512 * i; const f32x4* zr = (const f32x4*)(z2 + (size_t)t * 64);
                float af = 0.f, ab = 0.f;
#pragma unroll
                for (int j4 = 0; j4 < 16; ++j4) { const f32x4 z = zr[j4];
#pragma unroll
                    for (int e = 0; e < 4; ++e) { af += z[e] * w3s[j4 * 4 + e]; ab += z[e] * w3s[64 + j4 * 4 + e]; } }
                const float tt = (float)t * (1.f / 4096.f);
                af *= expf(-df * tt); ab *= expf(-db * tt);
                if (t == 0) { data[0] = make_float2(af + sk, 0.f); data[4096] = make_float2(0.f, 0.f); }
                else { data[t] = make_float2(af, 0.f); data[8192 - t] = make_float2(ab, 0.f); } }
            fft_fwd(data, tw, 4096, tid);
            float2* sp = (float2*)(P.ws + OFF_SPECL) + (size_t)(o * 512 + c) * 8192;
            for (int i = 0; i < 16; ++i) { const int p = tid + 512 * i; const float2 v = data[p]; sp[p] = make_float2(v.x * (1.f / 8192.f), v.y * (1.f / 8192.f)); }
        }
        for (int it = blockIdx.x; it < 64; it += gridDim.x) {
            const int o = it >> 5, c0 = (it & 31) * 16;
            __syncthreads();
            const int q = tid >> 5, ts = tid & 31, c = c0 + q;
            const float df = fabsf(dec[o * 1024 + c]), db = fabsf(dec[o * 1024 + 512 + c]), sk = skp[o * 512 + c];
#pragma unroll 1
            for (int i = 0; i < 8; ++i) { const int t = ts + 32 * i; const float* zr = z2 + (size_t)(4096 + t) * 64;
                float af = 0.f, ab = 0.f;
#pragma unroll 4
                for (int j = 0; j < 64; ++j) { const float z = zr[j]; af += z * w3[j * 2048 + o * 1024 + c]; ab += z * w3[j * 2048 + o * 1024 + 512 + c]; }
                const float tt = (float)t * (1.f / 256.f);
                af *= expf(-df * tt); ab *= expf(-db * tt);
                if (t == 0) { data[q * 512] = make_float2(af + sk, 0.f); data[q * 512 + 256] = make_float2(0.f, 0.f); }
                else { data[q * 512 + t] = make_float2(af, 0.f); data[q * 512 + 512 - t] = make_float2(ab, 0.f); } }
            fft_fwd(data, tw, 256, tid);
            for (int i = 0; i < 16; ++i) { const int p = tid + 512 * i; const int qq = p >> 9, pp = p & 511; const float2 v = data[p];
                ((float2*)(P.ws + OFF_SPECS))[(size_t)(o * 512 + c0 + qq) * 512 + pp] = make_float2(v.x * (1.f / 512.f), v.y * (1.f / 512.f)); }
        }
        __syncthreads();
        float* s = (float*)smem;
        for (int it = blockIdx.x; it < 4352; it += gridDim.x) {
            int r = it;
            if (r < 3328) { transpose_item(P.in[I_WIN] + (size_t)layer * 2048 * INW, INW, (bf16_t*)(P.ws + OFF_WTIN), 0, r, s, tid); continue; } r -= 3328;
            if (r < 512) { transpose_item(P.in[I_WOUT] + (size_t)layer * 2048 * 2048, 2048, (bf16_t*)(P.ws + OFF_WTOUT), 0, r, s, tid); continue; } r -= 512;
            if (r < 192) { transpose_item(P.in[I_WUA] + (size_t)layer * 768 * 2048, 2048, (bf16_t*)(P.ws + OFF_WTUP), 0, r, s, tid); continue; } r -= 192;
            if (r < 128) { transpose_item(P.in[I_WUB] + (size_t)layer * 512 * 2048, 2048, (bf16_t*)(P.ws + OFF_WTUP), 768, r, s, tid); continue; } r -= 128;
            transpose_item(P.in[I_WUC] + (size_t)layer * 768 * 2048, 2048, (bf16_t*)(P.ws + OFF_WTUP), 1280, r, s, tid);
        }
    }
    const float* nw = P.in[I_NW] + layer * D;
    for (int it = blockIdx.x; it < ck.ntok / 64; it += gridDim.x) {
#pragma unroll 1
        for (int i = 0; i < 8; ++i) {
            const int r = it * 64 + wave * 8 + i, g = ck.tok0 + r;
            const float* x = (layer == 0) ? (g < NCTXTOK ? P.in[I_XP] + (size_t)g * D : P.in[I_XS] + (size_t)(g - NCTXTOK) * D) : P.out + (size_t)g * D;
            const float* md = (const float*)(P.ws + OFF_MOD) + ((size_t)layer * 9 + cond_of(g)) * 6144;
            f32x4 v[8]; float ss = 0.f;
#pragma unroll
            for (int j = 0; j < 8; ++j) { v[j] = *(const f32x4*)(x + lane * 4 + 256 * j); ss += v[j][0] * v[j][0] + v[j][1] * v[j][1] + v[j][2] * v[j][2] + v[j][3] * v[j][3]; }
            const float rstd = rsqrtf(wave_sum(ss) * (1.f / D) + 1e-6f);
            bf16_t* h = (bf16_t*)(P.ws + OFF_H) + (size_t)r * D;
#pragma unroll
            for (int j = 0; j < 8; ++j) { const int k = lane * 4 + 256 * j; const f32x4 w = *(const f32x4*)(nw + k), sh = *(const f32x4*)(md + k), sc = *(const f32x4*)(md + 2048 + k);
                f32x4 y;
#pragma unroll
                for (int e = 0; e < 4; ++e) y[e] = v[j][e] * rstd * w[e] * (1.f + sc[e]) + sh[e];
                u32x2 o; o.x = cvt_pk_bf16(y[0], y[1]); o.y = cvt_pk_bf16(y[2], y[3]); *(u32x2*)(h + k) = o; }
        }
    }
}

__device__ __forceinline__ void hy_transpose_item(const Params& P, float* s, const int layer, const Chunk ck, int item, int tid) {
    const int tb = item >> 5, cb = item & 31, t0 = tb * 64;
    const int ctxrows = ck.nctxb * 256;
    const int Ls = (t0 < ctxrows) ? 256 : 4096; const int tin = (t0 < ctxrows) ? (t0 & 255) : ((t0 - ck.lat_row0) & 4095);
    const bool first = (tin == 0), lastb = (tin + 64 == Ls);
    const bf16_t* U = (const bf16_t*)(P.ws + OFF_U7);
    for (int idx = tid; idx < 66 * 8; idx += NTHREADS) { const int rr = idx >> 3, ch = idx & 7;
        const bool valid = !((rr == 0 && first) || (rr == 65 && lastb));
        u32x4 w = (u32x4){0u, 0u, 0u, 0u};
        if (valid) w = *(const u32x4*)(U + (size_t)(t0 - 1 + rr) * U7W + 2048 + cb * 64 + ch * 8);
        float* d = s + rr * 65 + ch * 8; d[0] = bf_lo(w.x); d[1] = bf_hi(w.x); d[2] = bf_lo(w.y); d[3] = bf_hi(w.y); d[4] = bf_lo(w.z); d[5] = bf_hi(w.z); d[6] = bf_lo(w.w); d[7] = bf_hi(w.w); }
    __syncthreads();
    const int col = tid >> 3, tch = tid & 7, cc = cb * 64 + col;
    float o[8];
    if (cb < 24) { const float* cw = P.in[I_HCW] + (size_t)layer * 3 * 1536; const float w0 = cw[cc], w1 = cw[1536 + cc], w2 = cw[3072 + cc], bb = P.in[I_HCB][layer * 1536 + cc];
#pragma unroll
        for (int i = 0; i < 8; ++i) { const int t = tch * 8 + i; o[i] = bb + w0 * s[t * 65 + col] + w1 * s[(t + 1) * 65 + col] + w2 * s[(t + 2) * 65 + col]; } }
    else {
#pragma unroll
        for (int i = 0; i < 8; ++i) { const int t = tch * 8 + i; o[i] = s[(t + 1) * 65 + col]; } }
    u32x4 w; w.x = cvt_pk_bf16(o[0], o[1]); w.y = cvt_pk_bf16(o[2], o[3]); w.z = cvt_pk_bf16(o[4], o[5]); w.w = cvt_pk_bf16(o[6], o[7]);
    *(u32x4*)((bf16_t*)(P.ws + OFF_H) + (size_t)cc * ck.ntok + t0 + tch * 8) = w;
    __syncthreads();
}

__device__ __forceinline__ void attn_item(const Params& P, unsigned char* smem, const int layer, const Chunk ck, int kind, int b, int h, int qb) {
    int tid_ = threadIdx.x; asm volatile("" : "+v"(tid_));
    const int tid = tid_, lane = tid & 63, wave = tid >> 6, fr = lane & 15, fq = lane >> 4;
    bf16_t* Ks = (bf16_t*)smem; bf16_t* Vt = Ks + 64 * 72; float* rpbs = (float*)(smem + 2 * 64 * 72 * 2);
    bf16_t* U = (bf16_t*)(P.ws + OFF_U7);
    const bool lat = kind < 2, isA = (kind == 0 || kind == 2);
    const int seq_row0 = lat ? ck.lat_row0 + (b - ck.latb0) * 4096 : b * 256;
    const int q0 = qb * 128;
    const int kh = isA ? h / 3 : h;
    const int qcol = isA ? h * 64 : 4096 + h * 64, kcol = isA ? 768 + kh * 64 : 4864 + h * 64, vcol = isA ? 1024 + kh * 64 : 5632 + h * 64, gcol = isA ? 1280 + h * 64 : 6400 + h * 64;
    int lt0, nlt;
    if (kind == 0) { const int a = q0 - 128 < 0 ? 0 : q0 - 128, e = q0 + 256 > 4096 ? 4096 : q0 + 256; lt0 = a; nlt = (e - a) >> 6; }
    else if (kind == 1) { const int r0 = q0 >> 6; int rs0 = r0 - 4; rs0 = rs0 < 0 ? 0 : (rs0 > 56 ? 56 : rs0); int rs1 = r0 - 3; rs1 = rs1 < 0 ? 0 : (rs1 > 56 ? 56 : rs1); lt0 = rs0 * 64; nlt = rs1 + 8 - rs0; }
    else { lt0 = 0; nlt = 4; }
    const int nct = lat ? 8 : 0, ntiles = nct + nlt;
    const float* cK = isA ? P.in[I_CAK] : P.in[I_CCK]; const float* cV = isA ? P.in[I_CAV] : P.in[I_CCV]; const int HK = isA ? 4 : 12;
    const float2* rope = (const float2*)(P.ws + OFF_ROPE);
    const int qrow = q0 + wave * 16 + fr;
    __syncthreads();
    if (kind == 1) { for (int i = tid; i < 465; i += NTHREADS) rpbs[i] = P.in[I_RPB][((size_t)layer * 12 + h) * 465 + i]; }
    bf16x8 qf[2];
    {
        const bf16_t* qp = U + (size_t)(seq_row0 + qrow) * U7W + qcol + fq * 8;
        u32x4 a0 = *(const u32x4*)qp, a1 = *(const u32x4*)(qp + 32);
        if (kind == 0) {
            const int rr = qrow >> 6, cc = qrow & 63;
            float x1[8], x2[8];
#pragma unroll
            for (int e = 0; e < 4; ++e) { x1[2 * e] = bf_lo(a0[e]); x1[2 * e + 1] = bf_hi(a0[e]); x2[2 * e] = bf_lo(a1[e]); x2[2 * e + 1] = bf_hi(a1[e]); }
#pragma unroll
            for (int j = 0; j < 8; ++j) { const int i = fq * 8 + j; const float2 cs = (i < 16) ? rope[rr * 16 + i] : rope[cc * 16 + i - 16];
                const float o1 = x1[j] * cs.x - x2[j] * cs.y, o2 = x1[j] * cs.y + x2[j] * cs.x; x1[j] = o1; x2[j] = o2; }
#pragma unroll
            for (int e = 0; e < 4; ++e) { a0[e] = cvt_pk_bf16(x1[2 * e], x1[2 * e + 1]); a1[e] = cvt_pk_bf16(x2[2 * e], x2[2 * e + 1]); }
        }
        qf[0] = __builtin_bit_cast(bf16x8, a0); qf[1] = __builtin_bit_cast(bf16x8, a1);
    }
    float mrun, lsum;
    if (isA) { mrun = P.in[I_SINK][layer * 12 + h]; lsum = (fq == 0) ? 1.f : 0.f; } else { mrun = -1e30f; lsum = 0.f; }
    f32x4 o[4];
#pragma unroll
    for (int dt = 0; dt < 4; ++dt) o[dt] = (f32x4){0.f, 0.f, 0.f, 0.f};
    const int skey = tid >> 3, spc = tid & 7;
    for (int ti = 0; ti < ntiles; ++ti) {
        __syncthreads();
        {
            u32x4 kw, vw;
            if (ti < nct) {
                const size_t off = ((((size_t)b * 2 + layer) * PAST + (size_t)ti * 64 + skey) * HK + kh) * 64 + spc * 8;
                const f32x4 k0 = *(const f32x4*)(cK + off), k1 = *(const f32x4*)(cK + off + 4), v0 = *(const f32x4*)(cV + off), v1 = *(const f32x4*)(cV + off + 4);
                kw.x = cvt_pk_bf16(k0[0], k0[1]); kw.y = cvt_pk_bf16(k0[2], k0[3]); kw.z = cvt_pk_bf16(k1[0], k1[1]); kw.w = cvt_pk_bf16(k1[2], k1[3]);
                vw.x = cvt_pk_bf16(v0[0], v0[1]); vw.y = cvt_pk_bf16(v0[2], v0[3]); vw.z = cvt_pk_bf16(v1[0], v1[1]); vw.w = cvt_pk_bf16(v1[2], v1[3]);
            } else {
                const int tok = lt0 + (ti - nct) * 64 + skey;
                const bf16_t* rowp = U + (size_t)(seq_row0 + tok) * U7W;
                kw = *(const u32x4*)(rowp + kcol + spc * 8); vw = *(const u32x4*)(rowp + vcol + spc * 8);
                if (kind == 0) {
                    const u32x4 pw = *(const u32x4*)(rowp + kcol + (spc ^ 4) * 8);
                    const int rr = tok >> 6, cc = tok & 63; const bool lo = spc < 4;
#pragma unroll
                    for (int e = 0; e < 4; ++e) {
                        float r2[2];
#pragma unroll
                        for (int hh = 0; hh < 2; ++hh) { const int i = (spc & 3) * 8 + 2 * e + hh; const float2 cs = (i < 16) ? rope[rr * 16 + i] : rope[cc * 16 + i - 16];
                            const float mine = hh ? bf_hi(kw[e]) : bf_lo(kw[e]), oth = hh ? bf_hi(pw[e]) : bf_lo(pw[e]);
                            r2[hh] = lo ? (mine * cs.x - oth * cs.y) : (oth * cs.y + mine * cs.x); }
                        kw[e] = cvt_pk_bf16(r2[0], r2[1]); }
                }
            }
            *(u32x4*)(Ks + skey * 72 + spc * 8) = kw;
#pragma unroll
            for (int e = 0; e < 4; ++e) { Vt[(spc * 8 + 2 * e) * 72 + skey] = (bf16_t)(vw[e] & 0xffffu); Vt[(spc * 8 + 2 * e + 1) * 72 + skey] = (bf16_t)(vw[e] >> 16); }
        }
        __syncthreads();
        f32x4 sc[4];
#pragma unroll
        for (int st = 0; st < 4; ++st) { sc[st] = (f32x4){0.f, 0.f, 0.f, 0.f};
#pragma unroll
            for (int ks = 0; ks < 2; ++ks) { const bf16x8 a = *(const bf16x8*)(Ks + (st * 16 + fr) * 72 + ks * 32 + fq * 8); sc[st] = __builtin_amdgcn_mfma_f32_16x16x32_bf16(a, qf[ks], sc[st], 0, 0, 0); } }
        float mx = mrun;
        const bool local = ti >= nct; const int ttok0 = lt0 + (ti - nct) * 64;
#pragma unroll
        for (int st = 0; st < 4; ++st)
#pragma unroll
            for (int i = 0; i < 4; ++i) { float sv = sc[st][i] * 0.125f; const int kk = st * 16 + fq * 4 + i;
                if (local && kind == 0) { const int d = qrow - (ttok0 + kk); if (d > 128 || d < -128) sv = -1e30f; }
                if (local && kind == 1) { const int kr = ttok0 >> 6, r = qrow >> 6, w = qrow & 63; int rs = r - 4; rs = rs < 0 ? 0 : (rs > 56 ? 56 : rs); int cs = w - 8; cs = cs < 0 ? 0 : (cs > 48 ? 48 : cs);
                    const bool ok = (kr >= rs) && (kr < rs + 8) && (kk >= cs) && (kk < cs + 16);
                    const int bi = ok ? (kr - r + 7) * 31 + (kk - w + 15) : 0; const float bias = rpbs[bi]; sv = ok ? sv + bias : -1e30f; }
                sc[st][i] = sv; mx = fmaxf(mx, sv); }
        mx = fmaxf(mx, __shfl_xor(mx, 16)); mx = fmaxf(mx, __shfl_xor(mx, 32));
        const float alpha = __expf(mrun - mx); mrun = mx; lsum *= alpha;
#pragma unroll
        for (int dt = 0; dt < 4; ++dt) o[dt] *= alpha;
#pragma unroll
        for (int st = 0; st < 4; ++st)
#pragma unroll
            for (int i = 0; i < 4; ++i) { const float p = __expf(sc[st][i] - mx); lsum += p; sc[st][i] = p; }
#pragma unroll
        for (int k2 = 0; k2 < 2; ++k2) {
            u32x4 pw; pw.x = cvt_pk_bf16(sc[2 * k2][0], sc[2 * k2][1]); pw.y = cvt_pk_bf16(sc[2 * k2][2], sc[2 * k2][3]); pw.z = cvt_pk_bf16(sc[2 * k2 + 1][0], sc[2 * k2 + 1][1]); pw.w = cvt_pk_bf16(sc[2 * k2 + 1][2], sc[2 * k2 + 1][3]);
            const bf16x8 pb = __builtin_bit_cast(bf16x8, pw);
#pragma unroll
            for (int dt = 0; dt < 4; ++dt) { const bf16_t* vp = Vt + (dt * 16 + fr) * 72 + 32 * k2 + fq * 4;
                const u32x2 v0 = *(const u32x2*)vp, v1 = *(const u32x2*)(vp + 16);
                u32x4 aw; aw.x = v0.x; aw.y = v0.y; aw.z = v1.x; aw.w = v1.y;
                o[dt] = __builtin_amdgcn_mfma_f32_16x16x32_bf16(__builtin_bit_cast(bf16x8, aw), pb, o[dt], 0, 0, 0); }
        }
    }
    lsum += __shfl_xor(lsum, 16); lsum += __shfl_xor(lsum, 32);
    const float inv = 1.f / lsum;
    bf16_t* gp = U + (size_t)(seq_row0 + qrow) * U7W + gcol + fq * 4;
#pragma unroll
    for (int dt = 0; dt < 4; ++dt) { const u32x2 gw = *(const u32x2*)(gp + dt * 16);
        const float g0 = bf_lo(gw.x), g1 = bf_hi(gw.x), g2 = bf_lo(gw.y), g3 = bf_hi(gw.y);
        u32x2 ow; ow.x = cvt_pk_bf16(o[dt][0] * inv * g0 * sigmoidf_(g0), o[dt][1] * inv * g1 * sigmoidf_(g1)); ow.y = cvt_pk_bf16(o[dt][2] * inv * g2 * sigmoidf_(g2), o[dt][3] * inv * g3 * sigmoidf_(g3));
        *(u32x2*)(gp + dt * 16) = ow; }
}

__device__ __forceinline__ void phase3a(const Params& P, unsigned char* smem, const int layer, const Chunk ck) {
    int tid_ = threadIdx.x; asm volatile("" : "+v"(tid_));
    const int tid = tid_;
    const int n_latA = ck.nlatb * 12 * 32, n_ctxA = ck.nctxb * 12 * 2;
    const int n_attn = 2 * n_latA + 2 * n_ctxA;
    const int n_tr = (ck.ntok / 64) * 32;
    for (int it = blockIdx.x; it < n_attn + n_tr; it += gridDim.x) {
        if (it < n_attn) {
            int r = it, kind, b, h, qb;
            if (r < 2 * n_latA) { kind = r / n_latA; r -= kind * n_latA; b = ck.latb0 + r / 384; r %= 384; h = r / 32; qb = r % 32; }
            else { r -= 2 * n_latA; kind = 2 + r / n_ctxA; r %= n_ctxA; b = r / 24; r %= 24; h = r >> 1; qb = r & 1; }
            attn_item(P, smem, layer, ck, kind, b, h, qb);
        } else {
            __syncthreads();
            hy_transpose_item(P, (float*)smem, layer, ck, it - n_attn, tid);
        }
    }
}

__device__ __forceinline__ void phase3b(const Params& P, unsigned char* smem, const int layer, const Chunk ck) {
    int tid_ = threadIdx.x; asm volatile("" : "+v"(tid_));
    const int tid = tid_;
    float2* data = (float2*)smem; float2* tw = (float2*)(smem + 65536);
    fft_init_tw(tw, tid);
    const bf16_t* T = (const bf16_t*)(P.ws + OFF_H);
    bf16_t* U = (bf16_t*)(P.ws + OFF_U7);
    const int npair = ck.nlatb / 2, nlat_items = npair * 512, nctx_items = ck.nctxb ? 512 : 0;
    const size_t nt = (size_t)ck.ntok;
    for (int it = blockIdx.x; it < nlat_items + nctx_items; it += gridDim.x) {
        const bool lat = it < nlat_items;
        const int c = lat ? (it & 511) : ((it - nlat_items) & 511);
        const int pr = lat ? (it >> 9) : 0;
        const int mfirst = lat ? 4096 : 256;
        const bf16_t* tv = T + (size_t)c * nt; const bf16_t* tx1 = T + (size_t)(512 + c) * nt; const bf16_t* tx2 = T + (size_t)(1024 + c) * nt; const bf16_t* tg = T + (size_t)(1536 + c) * nt;
        const float2* sp0 = lat ? (const float2*)(P.ws + OFF_SPECL) + (size_t)c * 8192 : (const float2*)(P.ws + OFF_SPECS) + (size_t)c * 512;
        const float2* sp1 = lat ? sp0 + (size_t)512 * 8192 : sp0 + (size_t)512 * 512;
        __syncthreads();
#define HY_MAP(idx, valid, rA, rB) do { if (lat) { valid = (idx) < 4096; rA = ck.lat_row0 + pr * 8192 + (idx); rB = rA + 4096; } \
                                        else { const int q_ = (idx) >> 9, t_ = (idx) & 511; valid = t_ < 256; rA = q_ * 512 + t_; rB = rA + 256; } } while (0)
        for (int i = 0; i < 16; ++i) { const int idx = tid + 512 * i; bool valid; int rA, rB; HY_MAP(idx, valid, rA, rB);
            data[idx] = valid ? make_float2(bf2f(tv[rA]), bf2f(tv[rB])) : make_float2(0.f, 0.f); }
        fft_fwd(data, tw, mfirst, tid);
        for (int i = 0; i < 16; ++i) { const int p = tid + 512 * i; const float2 s = lat ? sp0[p] : sp0[p & 511]; const float2 v = data[p]; data[p] = make_float2(v.x * s.x - v.y * s.y, v.x * s.y + v.y * s.x); }
        fft_inv(data, tw, mfirst, tid);
        for (int i = 0; i < 16; ++i) { const int idx = tid + 512 * i; bool valid; int rA, rB; HY_MAP(idx, valid, rA, rB);
            const float2 v = data[idx]; data[idx] = valid ? make_float2(v.x * bf2f(tx1[rA]), v.y * bf2f(tx1[rB])) : make_float2(0.f, 0.f); }
        fft_fwd(data, tw, mfirst, tid);
        for (int i = 0; i < 16; ++i) { const int p = tid + 512 * i; const float2 s = lat ? sp1[p] : sp1[p & 511]; const float2 v = data[p]; data[p] = make_float2(v.x * s.x - v.y * s.y, v.x * s.y + v.y * s.x); }
        fft_inv(data, tw, mfirst, tid);
        for (int i = 0; i < 16; ++i) { const int idx = tid + 512 * i; bool valid; int rA, rB; HY_MAP(idx, valid, rA, rB);
            if (valid) { const float2 v = data[idx]; const float gA = bf2f(tg[rA]), gB = bf2f(tg[rB]);
                U[(size_t)rA * U7W + 3584 + c] = f2bf(v.x * bf2f(tx2[rA]) * gA * sigmoidf_(gA));
                U[(size_t)rB * U7W + 3584 + c] = f2bf(v.y * bf2f(tx2[rB]) * gB * sigmoidf_(gB)); } }
#undef HY_MAP
    }
}

__device__ __forceinline__ void phase_final(const Params& P) {
    int tid_ = threadIdx.x; asm volatile("" : "+v"(tid_));
    const int tid = tid_, lane = tid & 63, wave = tid >> 6;
    const float* fw = P.in[I_FNW];
    for (int it = blockIdx.x; it < 40960 / 8; it += gridDim.x) {
        const int g = it * 8 + wave; float* x = P.out + (size_t)g * D;
        f32x4 v[8]; float ss = 0.f;
#pragma unroll
        for (int j = 0; j < 8; ++j) { v[j] = *(const f32x4*)(x + lane * 4 + 256 * j); ss += v[j][0] * v[j][0] + v[j][1] * v[j][1] + v[j][2] * v[j][2] + v[j][3] * v[j][3]; }
        const float rstd = rsqrtf(wave_sum(ss) * (1.f / D) + 1e-6f);
#pragma unroll
        for (int j = 0; j < 8; ++j) { const int k = lane * 4 + 256 * j; const f32x4 w = *(const f32x4*)(fw + k); *(f32x4*)(x + k) = v[j] * rstd * w; }
    }
}

__global__ void __launch_bounds__(NTHREADS, 2) fwd_megakernel(Params P) {
    extern __shared__ __attribute__((aligned(16))) unsigned char smem[];
    cg::grid_group grid = cg::this_grid();
#ifndef PMASK
#define PMASK 0xff
#endif
    if (PMASK & 1) phase0(P, smem);
    grid.sync();
    for (int layer = 0; layer < 2; ++layer) {
        for (int c = 0; c < 2; ++c) {
            const Chunk ck = get_chunk(c);
            if (PMASK & 2) phase1(P, smem, layer, c, ck);
            grid.sync();
            if (PMASK & 4) gemm_phase<2>((LAS unsigned char*)smem, P, layer, ck);
            grid.sync();
            if (PMASK & 8) phase3a(P, smem, layer, ck);
            grid.sync();
            if (PMASK & 16) phase3b(P, smem, layer, ck);
            grid.sync();
            if (PMASK & 32) gemm_phase<4>((LAS unsigned char*)smem, P, layer, ck);
            grid.sync();
            if (PMASK & 64) gemm_phase<5>((LAS unsigned char*)smem, P, layer, ck);
            grid.sync();
        }
    }
    if (PMASK & 128) phase_final(P);
}

extern "C" void kernel_launch(void* const* d_in, const int* in_sizes, int n_in, void* d_out, int out_size, void* d_ws, size_t ws_size, hipStream_t stream) {
    static int grid_blocks = 0;
    if (grid_blocks == 0) {
        if (n_in != 29 || ws_size < WS_END) { fprintf(stderr, "kernel_launch: need 29 inputs and %zu bytes of workspace (got %d, %zu)\n", (size_t)WS_END, n_in, ws_size); grid_blocks = -1; return; }
        int dev = 0, cus = 0, per_cu = 0;
        hipGetDevice(&dev);
        hipDeviceGetAttribute(&cus, hipDeviceAttributeMultiprocessorCount, dev);
        if (hipFuncSetAttribute((const void*)fwd_megakernel, hipFuncAttributeMaxDynamicSharedMemorySize, LDS_BYTES) != hipSuccess) { fprintf(stderr, "kernel_launch: hipFuncSetAttribute failed\n"); grid_blocks = -1; return; }
        hipOccupancyMaxActiveBlocksPerMultiprocessor(&per_cu, (const void*)fwd_megakernel, NTHREADS, LDS_BYTES);
        if (per_cu < 1) per_cu = 1;
        grid_blocks = cus * per_cu;
        (void)hipGetLastError();
    }
    if (grid_blocks < 0) return;
    Params p{};
    for (int i = 0; i < 29; ++i) p.in[i] = (const float*)d_in[i];
    p.out = (float*)d_out; p.ws = (unsigned char*)d_ws;
    void* args[] = {&p};
    hipError_t e = hipLaunchCooperativeKernel((const void*)fwd_megakernel, dim3(grid_blocks), dim3(NTHREADS), args, LDS_BYTES, stream);
    if (e != hipSuccess) fprintf(stderr, "cooperative launch failed: %s (grid %d)\n", hipGetErrorString(e), grid_blocks);
}
```

```cpp
#include <hip/hip_runtime.h>
#include <hip/hip_cooperative_groups.h>
#include <cstdio>
#include <cstdint>
namespace cg = cooperative_groups;

#define LAS __attribute__((address_space(3)))
typedef unsigned short bf16_t;
typedef short bf16x8 __attribute__((ext_vector_type(8)));
typedef float f32x4 __attribute__((ext_vector_type(4)));
typedef unsigned u32x4 __attribute__((ext_vector_type(4)));
typedef unsigned u32x2 __attribute__((ext_vector_type(2)));

constexpr int D = 2048, NCTXTOK = 8192, LLAT = 4096, LCTX = 256, PAST = 512;
constexpr int INW = 13312, U7W = 7168, MGW = 6144;
constexpr int NTHREADS = 512;
constexpr int LDS_BYTES = 131072;
constexpr size_t OUT_AK = 83886080ull, OUT_AV = 88080384ull, OUT_CK = 92274688ull, OUT_CV = 104857600ull;
constexpr size_t OFF_MOD = 4096;
constexpr size_t OFF_ROPE = OFF_MOD + 2ull * 9 * 6144 * 4;
constexpr size_t OFF_Z2 = OFF_ROPE + 8192;
constexpr size_t OFF_WTIN = OFF_Z2 + 2ull * 4352 * 64 * 4;
constexpr size_t OFF_WTUP = OFF_WTIN + 13312ull * 2048 * 2;
constexpr size_t OFF_WTOUT = OFF_WTUP + 2048ull * 2048 * 2;
constexpr size_t OFF_SPECL = OFF_WTOUT + 2048ull * 2048 * 2;
constexpr size_t OFF_SPECS = OFF_SPECL + 2ull * 512 * 8192 * 8;
constexpr size_t OFF_H = OFF_SPECS + 2ull * 512 * 512 * 8;
constexpr size_t OFF_U7 = OFF_H + 24576ull * 2048 * 2;
constexpr size_t OFF_MG = OFF_U7 + 24576ull * 7168 * 2;
constexpr size_t WS_END = OFF_MG + 24576ull * 6144 * 2;

struct Params { const float* in[29]; float* out; unsigned char* ws; };
enum { I_XP = 0, I_XS, I_C, I_CAK, I_CAV, I_CCK, I_CCV, I_CCTX, I_NW, I_WADA, I_BADA, I_WIN, I_SINK, I_HCW, I_HCB, I_HW1, I_HB1, I_HW2, I_HB2,
       I_HFREQ, I_HW3, I_HDEC, I_HSKIP, I_RPB, I_WUA, I_WUB, I_WUC, I_WOUT, I_FNW };

struct Chunk { int tok0, ntok, nctxb, lat_row0, latb0, nlatb; };
__device__ __forceinline__ Chunk get_chunk(int c) { Chunk k; if (c == 0) { k.tok0 = 0; k.ntok = 24576; k.nctxb = 32; k.lat_row0 = 8192; k.latb0 = 0; k.nlatb = 4; } else { k.tok0 = 24576; k.ntok = 16384; k.nctxb = 0; k.lat_row0 = 0; k.latb0 = 4; k.nlatb = 4; } return k; }
__device__ __forceinline__ int cond_of(int g) { return g < NCTXTOK ? 0 : 1 + ((g - NCTXTOK) >> 12); }

__device__ __forceinline__ unsigned cvt_pk_bf16(float lo, float hi) { unsigned r; asm volatile("v_cvt_pk_bf16_f32 %0, %1, %2" : "=v"(r) : "v"(lo), "v"(hi)); return r; }
__device__ __forceinline__ float bf_lo(unsigned u) { return __uint_as_float(u << 16); }
__device__ __forceinline__ float bf_hi(unsigned u) { return __uint_as_float(u & 0xffff0000u); }
__device__ __forceinline__ float bf2f(bf16_t b) { return __uint_as_float(((unsigned)b) << 16); }
__device__ __forceinline__ bf16_t f2bf(float f) { return (bf16_t)(cvt_pk_bf16(f, 0.f) & 0xffffu); }
__device__ __forceinline__ float wave_sum(float v) {
#pragma unroll
    for (int o = 1; o < 64; o <<= 1) v += __shfl_xor(v, o);
    return v;
}
__device__ __forceinline__ float sigmoidf_(float x) { return 1.f / (1.f + __expf(-x)); }

constexpr int BM = 256, BK = 64, HALF = 128, HTB = HALF * BK * 2;
__device__ __forceinline__ int lds_byte(int r, int c) { const int st = (r >> 4) * 2 + (c >> 5), rr = r & 15, cc = c & 31, ob = rr * 64 + cc * 2; return st * 1024 + (ob ^ (((ob >> 9) & 1) << 5)); }
__device__ __forceinline__ void stage_rc(int b, int& R, int& C) { const int st = b / 1024, sb = b % 1024, swz = sb ^ (((sb >> 9) & 1) << 5); R = (st >> 1) * 16 + swz / 64; C = (st & 1) * 32 + (swz % 64) / 2; }
__device__ __forceinline__ int perm32(int rho) { const int n = rho >> 4, i = rho & 15; return 8 * (i >> 2) + 4 * n + (i & 3); }

struct GSched { int nM, nN, ntile, G, c; };
template <int PER>
__device__ __forceinline__ bool gs_next(const GSched& S, int ui, int& pm, int& pn, int& br) {
    const int round = ui / PER; br = ui - round * PER;
    const long L = (long)round * S.G + S.c; if (L >= S.ntile) return false;
    int wgid = (int)L; { const int q = S.ntile / 8, r = S.ntile % 8, xcd = wgid % 8, off = wgid / 8; wgid = (xcd < r ? xcd * (q + 1) : r * (q + 1) + (xcd - r) * q) + off; }
    const int nig = 8 * S.nN, gid = wgid / nig, fm = gid * 8, gsz = (S.nM - fm) < 8 ? (S.nM - fm) : 8;
    pm = fm + ((wgid % nig) % gsz); pn = (wgid % nig) / gsz; return true;
}

template <int MODE>
__device__ __forceinline__ void gemm_phase(LAS unsigned char* lds, const Params& P, const int layer, const Chunk ck) {
    constexpr bool PERM = (MODE != 5);
    constexpr int PER = (MODE == 4) ? 3 : 1;
    int tid_ = threadIdx.x; asm volatile("" : "+v"(tid_));
    const int tid = tid_, wid = __builtin_amdgcn_readfirstlane(tid >> 6), lane = tid & 63, wr = wid >> 2, wc = wid & 3, fr = lane & 15, fq = lane >> 4;
    const char* Abase; const char* Bbase; unsigned lda, ldb; int nN;
    if (MODE == 2) { Abase = (const char*)(P.ws + OFF_H); lda = 4096u; Bbase = (const char*)(P.ws + OFF_WTIN); ldb = 4096u; nN = 52; }
    else if (MODE == 4) { Abase = (const char*)(P.ws + OFF_U7); lda = 14336u; Bbase = (const char*)(P.ws + OFF_WTUP); ldb = 4096u; nN = 8; }
    else { Abase = (const char*)(P.ws + OFF_H); lda = 4096u; Bbase = (const char*)(P.ws + OFF_WTOUT); ldb = 4096u; nN = 8; }
    GSched S; S.nM = ck.ntok / 256; S.nN = nN; S.ntile = S.nM * nN; S.G = (int)gridDim.x; S.c = (int)blockIdx.x;
    unsigned voffA[2], voffB[2];
#pragma unroll
    for (int i = 0; i < 2; ++i) { int R, C; stage_rc(tid * 16 + i * 8192, R, C); const int Rb = PERM ? ((R & ~31) + perm32(R & 31)) : R;
        voffA[i] = (unsigned)R * lda + (unsigned)C * 2u; voffB[i] = (unsigned)Rb * ldb + (unsigned)C * 2u; }
    const size_t kstep = (size_t)(BK * 2);
    const size_t hstepA = (size_t)HALF * lda, hstepB = (size_t)HALF * ldb;
    const unsigned ldsw = (unsigned)wid * 1024u;
    const int aoff = lds_byte(wr * 64 + fr, fq * 8), boff = lds_byte(wc * 32 + fr, fq * 8);
#define PG8_SA(b, h) (((b) * 2 + (h)) * HTB)
#define PG8_SB(b, h) ((4 + (b) * 2 + (h)) * HTB)
#define PG8_STAGE(bufoff, gbase, voff) do { _Pragma("unroll") for (int _i = 0; _i < 2; ++_i) \
        __builtin_amdgcn_global_load_lds((const unsigned*)((const char*)(gbase) + (voff)[_i]), (LAS unsigned*)(lds + (bufoff) + ldsw + _i * 8192), 16, 0, 0); } while (0)
#define PG8_LDA(dst, b, h) do { _Pragma("unroll") for (int m = 0; m < 4; ++m) _Pragma("unroll") for (int k = 0; k < 2; ++k) dst[m][k] = *(const LAS bf16x8*)(lds + PG8_SA(b, h) + aoff + m * 2048 + k * 1024); } while (0)
#define PG8_LDB(dst, b, h) do { _Pragma("unroll") for (int n = 0; n < 2; ++n) _Pragma("unroll") for (int k = 0; k < 2; ++k) dst[n][k] = *(const LAS bf16x8*)(lds + PG8_SB(b, h) + boff + n * 2048 + k * 1024); } while (0)
#define PG8_MMA(ai, bj, At, Bt) do { __builtin_amdgcn_s_setprio(1); _Pragma("unroll") for (int m = 0; m < 4; ++m) _Pragma("unroll") for (int n = 0; n < 2; ++n) _Pragma("unroll") for (int k = 0; k < 2; ++k) \
        acc[ai][bj][m][n] = __builtin_amdgcn_mfma_f32_16x16x32_bf16(Bt[n][k], At[m][k], acc[ai][bj][m][n], 0, 0, 0); __builtin_amdgcn_s_setprio(0); } while (0)
#define PG8_WAIT_V(n) asm volatile("s_waitcnt vmcnt(" #n ")" ::: "memory")
#define PG8_WAIT_L(n) asm volatile("s_waitcnt lgkmcnt(" #n ")" ::: "memory")
#define PG8_BAR __builtin_amdgcn_s_barrier()
#define PG8_SCHED __builtin_amdgcn_sched_barrier(0)
#define UNIT_PTRS(pm_, pn_, br_, a_, b_, nt_) do { \
        if (MODE == 4) { const int acol = (br_) == 0 ? 1280 : ((br_) == 1 ? 3584 : 6400), bk = (br_) == 0 ? 0 : ((br_) == 1 ? 768 : 1280); nt_ = (br_) == 1 ? 8 : 12; \
            a_ = Abase + (size_t)(pm_) * 256 * lda + (size_t)acol * 2; b_ = Bbase + (size_t)(pn_) * 256 * ldb + (size_t)bk * 2; } \
        else { nt_ = 32; a_ = Abase + (size_t)(pm_) * 256 * lda; b_ = Bbase + (size_t)(pn_) * 256 * ldb; } } while (0)
    int pm, pn, br, npm, npn, nbr; int ui = 0;
    if (!gs_next<PER>(S, 0, pm, pn, br)) return;
    f32x4 acc[2][2][4][2];
#pragma unroll
    for (int a = 0; a < 2; ++a)
#pragma unroll
        for (int b = 0; b < 2; ++b)
#pragma unroll
            for (int m = 0; m < 4; ++m)
#pragma unroll
                for (int n = 0; n < 2; ++n) acc[a][b][m][n] = (f32x4){0.f, 0.f, 0.f, 0.f};
    bf16x8 At[4][2], B0[2][2], B1[2][2];
    const char* cA; const char* cB; int nt;
    UNIT_PTRS(pm, pn, br, cA, cB, nt);
    PG8_STAGE(PG8_SB(0, 0), cB, voffB); PG8_STAGE(PG8_SB(0, 1), cB + hstepB, voffB); PG8_STAGE(PG8_SA(0, 0), cA, voffA); PG8_STAGE(PG8_SA(0, 1), cA + hstepA, voffA);
    if (wr == 1) PG8_BAR;
    PG8_WAIT_V(2); PG8_BAR;
    PG8_STAGE(PG8_SB(1, 0), cB + kstep, voffB); PG8_STAGE(PG8_SA(1, 0), cA + kstep, voffA); PG8_STAGE(PG8_SB(1, 1), cB + hstepB + kstep, voffB);
    PG8_WAIT_V(6); PG8_BAR;
    for (;;) {
        const bool has_next = gs_next<PER>(S, ui + 1, npm, npn, nbr);
        const char* nA = cA; const char* nB = cB; int nnt = nt;
        if (has_next) { UNIT_PTRS(npm, npn, nbr, nA, nB, nnt); }
        for (int t = 0; t < nt; t += 2) {
            const bool last = (t == nt - 2);
            const char* a1 = cA + (size_t)(t + 1) * kstep;
            const char* a2 = last ? nA : cA + (size_t)(t + 2) * kstep; const char* b2 = last ? nB : cB + (size_t)(t + 2) * kstep;
            const char* a3 = a2 + kstep; const char* b3 = b2 + kstep;
            PG8_LDB(B0, 0, 0); PG8_LDB(B1, 0, 1); PG8_SCHED; PG8_LDA(At, 0, 0); PG8_STAGE(PG8_SA(1, 1), a1 + hstepA, voffA);
            PG8_WAIT_V(8); PG8_WAIT_L(0); PG8_BAR; PG8_MMA(0, 0, At, B0); PG8_MMA(0, 1, At, B1); PG8_BAR; PG8_SCHED;
            PG8_LDA(At, 0, 1); PG8_STAGE(PG8_SB(0, 0), b2, voffB); PG8_STAGE(PG8_SB(0, 1), b2 + hstepB, voffB); PG8_STAGE(PG8_SA(0, 0), a2, voffA);
            PG8_WAIT_V(8); PG8_WAIT_L(0); PG8_BAR; PG8_MMA(1, 0, At, B0); PG8_MMA(1, 1, At, B1); PG8_BAR; PG8_SCHED;
            PG8_LDB(B0, 1, 0); PG8_LDB(B1, 1, 1); PG8_SCHED; PG8_LDA(At, 1, 0); PG8_STAGE(PG8_SA(0, 1), a2 + hstepA, voffA);
            PG8_WAIT_V(8); PG8_WAIT_L(0); PG8_BAR; PG8_MMA(0, 0, At, B0); PG8_MMA(0, 1, At, B1); PG8_BAR; PG8_SCHED;
            PG8_LDA(At, 1, 1); PG8_STAGE(PG8_SB(1, 0), b3, voffB); PG8_STAGE(PG8_SB(1, 1), b3 + hstepB, voffB); PG8_STAGE(PG8_SA(1, 0), a3, voffA);
            PG8_WAIT_V(8); PG8_WAIT_L(0); PG8_BAR; PG8_MMA(1, 0, At, B0); PG8_MMA(1, 1, At, B1); PG8_BAR; PG8_SCHED;
        }
        if (wr == 0) PG8_BAR;
        {
            const int row0 = pm * BM + wr * 64 + fr;
            if (MODE == 2) {
                const int colt = pn * BM + wc * 32 + 8 * fq;
                const bool isu = pn < 28;
                bf16_t* dst = isu ? (bf16_t*)(P.ws + OFF_U7) + colt : (bf16_t*)(P.ws + OFF_MG) + (colt - U7W);
                const int ldd = isu ? U7W : MGW;
                float* kvo = nullptr; int kvw = 0, kvc = 0;
                if (ck.tok0 + pm * BM < NCTXTOK) {
                    if (pn == 3) { kvo = P.out + OUT_AK; kvw = 256; kvc = colt - 768; }
                    else if (pn == 4) { kvo = P.out + OUT_AV; kvw = 256; kvc = colt - 1024; }
                    else if (pn >= 19 && pn < 22) { kvo = P.out + OUT_CK; kvw = 768; kvc = colt - 4864; }
                    else if (pn >= 22 && pn < 25) { kvo = P.out + OUT_CV; kvw = 768; kvc = colt - 5632; }
                }
#pragma unroll
                for (int ai = 0; ai < 2; ++ai)
#pragma unroll
                    for (int m = 0; m < 4; ++m) {
                        const int r = row0 + ai * HALF + m * 16;
#pragma unroll
                        for (int bj = 0; bj < 2; ++bj) {
                            const f32x4 v0 = acc[ai][bj][m][0], v1 = acc[ai][bj][m][1];
                            u32x4 w; w.x = cvt_pk_bf16(v0[0], v0[1]); w.y = cvt_pk_bf16(v0[2], v0[3]); w.z = cvt_pk_bf16(v1[0], v1[1]); w.w = cvt_pk_bf16(v1[2], v1[3]);
                            *(u32x4*)(dst + (size_t)r * ldd + bj * HALF) = w;
                            if (kvo) { const int g = ck.tok0 + r; const int bb = g >> 8, s = g & 255;
                                float* o = kvo + ((size_t)(bb * 2 + layer) * 256 + s) * kvw + kvc + bj * HALF;
                                *(f32x4*)o = v0; *(f32x4*)(o + 4) = v1; }
                        }
                    }
            } else if (MODE == 4) {
                const int colt = pn * BM + wc * 32 + 8 * fq;
                const bf16_t* mg = (const bf16_t*)(P.ws + OFF_MG);
                bf16_t* mo = (bf16_t*)(P.ws + OFF_H);
#pragma unroll
                for (int ai = 0; ai < 2; ++ai)
#pragma unroll
                    for (int m = 0; m < 4; ++m) {
                        const int r = row0 + ai * HALF + m * 16;
#pragma unroll
                        for (int bj = 0; bj < 2; ++bj) {
                            const int c0 = colt + bj * HALF;
                            const bf16_t* mr = mg + (size_t)r * MGW + c0;
                            float f[8];
                            if (br == 0) { const u32x4 ga = *(const u32x4*)mr, gb = *(const u32x4*)(mr + 2048);
#pragma unroll
                                for (int e = 0; e < 4; ++e) { f[2 * e] = (1.f + __expf(-bf_lo(gb[e]))) / (1.f + __expf(-bf_lo(ga[e]))); f[2 * e + 1] = (1.f + __expf(-bf_hi(gb[e]))) / (1.f + __expf(-bf_hi(ga[e]))); } }
                            else if (br == 1) { const u32x4 ga = *(const u32x4*)(mr + 2048), gb = *(const u32x4*)(mr + 4096);
#pragma unroll
                                for (int e = 0; e < 4; ++e) { f[2 * e] = (1.f + __expf(-bf_lo(gb[e]))) / (1.f + __expf(-bf_lo(ga[e]))); f[2 * e + 1] = (1.f + __expf(-bf_hi(gb[e]))) / (1.f + __expf(-bf_hi(ga[e]))); } }
                            else { const u32x4 ga = *(const u32x4*)(mr + 4096);
#pragma unroll
                                for (int e = 0; e < 4; ++e) { f[2 * e] = 1.f / (1.f + __expf(-bf_lo(ga[e]))); f[2 * e + 1] = 1.f / (1.f + __expf(-bf_hi(ga[e]))); } }
                            f32x4 v0 = acc[ai][bj][m][0], v1 = acc[ai][bj][m][1];
                            v0[0] *= f[0]; v0[1] *= f[1]; v0[2] *= f[2]; v0[3] *= f[3]; v1[0] *= f[4]; v1[1] *= f[5]; v1[2] *= f[6]; v1[3] *= f[7];
                            if (br == 2) { u32x4 w; w.x = cvt_pk_bf16(v0[0], v0[1]); w.y = cvt_pk_bf16(v0[2], v0[3]); w.z = cvt_pk_bf16(v1[0], v1[1]); w.w = cvt_pk_bf16(v1[2], v1[3]);
                                *(u32x4*)(mo + (size_t)r * D + c0) = w; v0 = (f32x4){0.f, 0.f, 0.f, 0.f}; v1 = v0; }
                            acc[ai][bj][m][0] = v0; acc[ai][bj][m][1] = v1;
                        }
                    }
            } else {
                const int colt = pn * BM + wc * 32 + 4 * fq;
#pragma unroll
                for (int ai = 0; ai < 2; ++ai)
#pragma unroll
                    for (int m = 0; m < 4; ++m) {
                        const int r = row0 + ai * HALF + m * 16; const int g = ck.tok0 + r;
                        const float* xo = (layer == 0) ? (g < NCTXTOK ? P.in[I_XP] + (size_t)g * D : P.in[I_XS] + (size_t)(g - NCTXTOK) * D) : P.out + (size_t)g * D;
                        float* yo = P.out + (size_t)g * D;
                        const float* gt = (const float*)(P.ws + OFF_MOD) + ((size_t)layer * 9 + cond_of(g)) * 6144 + 4096;
#pragma unroll
                        for (int bj = 0; bj < 2; ++bj)
#pragma unroll
                            for (int n = 0; n < 2; ++n) { const int c = colt + bj * HALF + n * 16;
                                const f32x4 xv = *(const f32x4*)(xo + c), gv = *(const f32x4*)(gt + c);
                                *(f32x4*)(yo + c) = xv + gv * acc[ai][bj][m][n]; }
                    }
            }
        }
        if (!has_next) break;
        if (MODE != 4) {
#pragma unroll
            for (int a = 0; a < 2; ++a)
#pragma unroll
                for (int b = 0; b < 2; ++b)
#pragma unroll
                    for (int m = 0; m < 4; ++m)
#pragma unroll
                        for (int n = 0; n < 2; ++n) acc[a][b][m][n] = (f32x4){0.f, 0.f, 0.f, 0.f};
        }
        pm = npm; pn = npn; br = nbr; cA = nA; cB = nB; nt = nnt; ++ui;
        if (wr == 1) PG8_BAR;
    }
    PG8_WAIT_V(0);
    PG8_BAR;
#undef PG8_SA
#undef PG8_SB
#undef PG8_STAGE
#undef PG8_LDA
#undef PG8_LDB
#undef PG8_MMA
#undef PG8_WAIT_V
#undef PG8_WAIT_L
#undef PG8_BAR
#undef PG8_SCHED
#undef UNIT_PTRS
}

#define PHYS(i) ((i) + ((i) >> 4))
constexpr int FFT_DATA_BYTES = (8192 + 512) * 8;
__device__ __forceinline__ float2 cmul(float2 a, float2 b) { return make_float2(a.x * b.x - a.y * b.y, a.x * b.y + a.y * b.x); }
__device__ __forceinline__ float2 cmulc(float2 a, float2 b) { return make_float2(a.x * b.x + a.y * b.y, a.y * b.x - a.x * b.y); }
__device__ __forceinline__ float2 root16(int n) {
    const float c1 = 0.92387953251128674f, s1 = 0.38268343236508977f, h = 0.70710678118654752f;
    switch (n) { case 0: return make_float2(1.f, 0.f); case 1: return make_float2(c1, -s1); case 2: return make_float2(h, -h); case 3: return make_float2(s1, -c1);
                 case 4: return make_float2(0.f, -1.f); case 5: return make_float2(-s1, -c1); case 6: return make_float2(-h, -h); default: return make_float2(-c1, -s1); }
}
template <int R, bool INV, bool TW>
__device__ __forceinline__ void fft_regs(float2 (&x)[1 << R], const float2 (&w)[R]) {
    constexpr int NP = 1 << R;
    if (!INV) {
#pragma unroll
        for (int s = 0; s < R; ++s) { const int h = 1 << (R - 1 - s);
#pragma unroll
            for (int k = 0; k < NP; ++k) if (!(k & h)) { const int q = k & (h - 1);
                const float2 a = x[k], b = x[k + h]; x[k] = make_float2(a.x + b.x, a.y + b.y);
                float2 t = make_float2(a.x - b.x, a.y - b.y); if (TW) t = cmul(t, w[s]); x[k + h] = cmul(t, root16(q * (8 / h))); } }
    } else {
#pragma unroll
        for (int s = R - 1; s >= 0; --s) { const int h = 1 << (R - 1 - s);
#pragma unroll
            for (int k = 0; k < NP; ++k) if (!(k & h)) { const int q = k & (h - 1);
                const float2 a = x[k]; float2 b = cmulc(x[k + h], root16(q * (8 / h))); if (TW) b = cmulc(b, w[s]);
                x[k] = make_float2(a.x + b.x, a.y + b.y); x[k + h] = make_float2(a.x - b.x, a.y - b.y); } }
    }
}
template <int S, int R, bool INV>
__device__ __forceinline__ void fft_pass(float2* d, const float2* tw, int tid) {
    constexpr int NP = 1 << R, GPT = (8192 >> R) / NTHREADS;
#pragma unroll
    for (int g = 0; g < GPT; ++g) {
        const int gid = tid + NTHREADS * g, r = gid & (S - 1), base = (gid / S) * (S << R) + r;
        float2 x[NP], w[R];
#pragma unroll
        for (int k = 0; k < NP; ++k) x[k] = d[PHYS(base + k * S)];
        w[0] = tw[r * (8192 / (S << R))];
#pragma unroll
        for (int s = 1; s < R; ++s) w[s] = cmul(w[s - 1], w[s - 1]);
        fft_regs<R, INV, true>(x, w);
#pragma unroll
        for (int k = 0; k < NP; ++k) d[PHYS(base + k * S)] = x[k];
    }
    __syncthreads();
}
__device__ __forceinline__ void fft_fwd_hi(float2* d, const float2* tw, bool lng, int tid) {
    if (lng) fft_pass<512, 4, false>(d, tw, tid);
    fft_pass<128, 2, false>(d, tw, tid);
    fft_pass<16, 3, false>(d, tw, tid);
}
__device__ __forceinline__ void fft_inv_hi(float2* d, const float2* tw, bool lng, int tid) {
    fft_pass<16, 3, true>(d, tw, tid);
    fft_pass<128, 2, true>(d, tw, tid);
    if (lng) fft_pass<512, 4, true>(d, tw, tid);
}
template <bool CONV>
__device__ __forceinline__ void fft_mid(float2* d, const float2* spec_in, float2* spec_out, float scale, int spmask, int tid) {
    float2 x[16]; const float2 w[4] = {make_float2(1.f, 0.f), make_float2(1.f, 0.f), make_float2(1.f, 0.f), make_float2(1.f, 0.f)};
    float2* p = d + 17 * tid;
#pragma unroll
    for (int k = 0; k < 16; ++k) x[k] = p[k];
    fft_regs<4, false, false>(x, w);
    if (CONV) {
        const f32x4* sp = (const f32x4*)(spec_in + ((16 * tid) & spmask));
#pragma unroll
        for (int k2 = 0; k2 < 8; ++k2) { const f32x4 sv = sp[k2]; x[2 * k2] = cmul(x[2 * k2], make_float2(sv[0], sv[1])); x[2 * k2 + 1] = cmul(x[2 * k2 + 1], make_float2(sv[2], sv[3])); }
        fft_regs<4, true, false>(x, w);
#pragma unroll
        for (int k = 0; k < 16; ++k) p[k] = x[k];
    } else {
        f32x4* so = (f32x4*)(spec_out + 16 * tid);
#pragma unroll
        for (int k2 = 0; k2 < 8; ++k2) so[k2] = (f32x4){x[2 * k2].x * scale, x[2 * k2].y * scale, x[2 * k2 + 1].x * scale, x[2 * k2 + 1].y * scale};
    }
    __syncthreads();
}
__device__ __forceinline__ void fft_init_tw(float2* tw, int tid) {
    for (int k = tid; k < 4096; k += NTHREADS) { float s, c; sincospif((float)k * (1.f / 4096.f), &s, &c); tw[k] = make_float2(c, -s); }
    __syncthreads();
}

__device__ __forceinline__ void phase0(const Params& P, unsigned char* smem) {
    int tid_ = threadIdx.x; asm volatile("" : "+v"(tid_));
    const int tid = tid_, lane = tid & 63, wave = tid >> 6;
    for (int it = blockIdx.x; it < 192 + 1 + 136; it += gridDim.x) {
        __syncthreads();
        if (it < 192) {
            const int l = it / 96, col0 = (it % 96) * 64;
            float* s = (float*)smem; float* red = (float*)(smem + 9 * 2048 * 4);
            for (int i = tid; i < 9 * 2048; i += NTHREADS) { const int v = i >> 11, k = i & 2047; const float x = (v == 0) ? P.in[I_CCTX][k] : P.in[I_C][(v - 1) * 2048 + k]; s[i] = x / (1.f + expf(-x)); }
            __syncthreads();
            const int kg = tid >> 4, cj = tid & 15;
            float acc[9][4];
#pragma unroll
            for (int v = 0; v < 9; ++v) { acc[v][0] = 0.f; acc[v][1] = 0.f; acc[v][2] = 0.f; acc[v][3] = 0.f; }
            const float* wp = P.in[I_WADA] + (size_t)l * 2048 * 6144 + col0 + 4 * cj;
#pragma unroll 4
            for (int k = kg; k < 2048; k += 32) { const f32x4 w = *(const f32x4*)(wp + (size_t)k * 6144);
#pragma unroll
                for (int v = 0; v < 9; ++v) { const float sv = s[v * 2048 + k]; acc[v][0] += sv * w[0]; acc[v][1] += sv * w[1]; acc[v][2] += sv * w[2]; acc[v][3] += sv * w[3]; } }
#pragma unroll
            for (int v = 0; v < 9; ++v)
#pragma unroll
                for (int e = 0; e < 4; ++e) { float a = acc[v][e]; a += __shfl_xor(a, 16); a += __shfl_xor(a, 32); acc[v][e] = a; }
            if (lane < 16) {
#pragma unroll
                for (int v = 0; v < 9; ++v)
#pragma unroll
                    for (int e = 0; e < 4; ++e) red[(wave * 16 + cj) * 36 + v * 4 + e] = acc[v][e];
            }
            __syncthreads();
            for (int i = tid; i < 9 * 64; i += NTHREADS) { const int v = i >> 6, cc = i & 63; float a = P.in[I_BADA][l * 6144 + col0 + cc];
                for (int w = 0; w < 8; ++w) a += red[(w * 16 + (cc >> 2)) * 36 + v * 4 + (cc & 3)];
                ((float*)(P.ws + OFF_MOD))[((size_t)l * 9 + v) * 6144 + col0 + cc] = a; }
        } else if (it == 192) {
            float2* tab = (float2*)(P.ws + OFF_ROPE);
            for (int i = tid; i < 1024; i += NTHREADS) { const int pos = i >> 4, f = i & 15; const float inv = powf(10000.f, -(float)f / 16.f); const float ang = (float)pos * inv; tab[i] = make_float2(cosf(ang), sinf(ang)); }
        } else {
            const int j = it - 193, l = j / 68, tb = j % 68;
            const bool lng = tb < 64; const int t0 = lng ? tb * 64 : (tb - 64) * 64; const float invL = lng ? (1.f / 4096.f) : (1.f / 256.f);
            const int rowoff = l * 4352 + (lng ? 0 : 4096) + t0;
            float* feats = (float*)smem; float* z1 = feats + 64 * 33;
            for (int i = tid; i < 64 * 33; i += NTHREADS) { const int tl = i / 33, f = i % 33; const float t = (float)(t0 + tl) * invL;
                float v; if (f == 0) v = t; else if (f <= 16) v = sinpif(2.f * (float)f * t); else v = cospif(2.f * (float)(f - 16) * t); feats[i] = v; }
            __syncthreads();
            const int tl = tid >> 3, part = tid & 7;
            const float* w1 = P.in[I_HW1] + (size_t)l * 33 * 64; const float* b1 = P.in[I_HB1] + l * 64; const float* fr0 = P.in[I_HFREQ] + l * 128;
            for (int jj = 0; jj < 8; ++jj) { const int jo = part * 8 + jj; float a = b1[jo];
                for (int f = 0; f < 33; ++f) a += feats[tl * 33 + f] * w1[f * 64 + jo];
                z1[tl * 65 + jo] = sinf(fr0[jo] * a); }
            __syncthreads();
            const float* w2 = P.in[I_HW2] + (size_t)l * 64 * 64; const float* b2 = P.in[I_HB2] + l * 64; const float* fr1 = fr0 + 64;
            float* z2 = (float*)(P.ws + OFF_Z2);
            for (int jj = 0; jj < 8; ++jj) { const int jo = part * 8 + jj; float a = b2[jo];
                for (int f = 0; f < 64; ++f) a += z1[tl * 65 + f] * w2[f * 64 + jo];
                z2[(size_t)(rowoff + tl) * 64 + jo] = sinf(fr1[jo] * a); }
        }
    }
}

__device__ __forceinline__ void transpose_item(const float* W, int N, bf16_t* WT, int koff, int item, float* s, int tid) {
    const int nb = N / 128, kb = item / nb, nbk = item % nb, k0 = kb * 64, n0 = nbk * 128;
#pragma unroll
    for (int i = 0; i < 4; ++i) { const int kk = i * 16 + (tid >> 5), c4 = tid & 31; const f32x4 w = *(const f32x4*)(W + (size_t)(k0 + kk) * N + n0 + 4 * c4);
        float* d = s + kk * 129 + 4 * c4; d[0] = w[0]; d[1] = w[1]; d[2] = w[2]; d[3] = w[3]; }
    __syncthreads();
#pragma unroll
    for (int j = 0; j < 2; ++j) { const int n = (tid >> 3) + 64 * j, c8 = tid & 7; const float* q = s + (8 * c8) * 129 + n;
        u32x4 o; o.x = cvt_pk_bf16(q[0], q[129]); o.y = cvt_pk_bf16(q[2 * 129], q[3 * 129]); o.z = cvt_pk_bf16(q[4 * 129], q[5 * 129]); o.w = cvt_pk_bf16(q[6 * 129], q[7 * 129]);
        *(u32x4*)(WT + (size_t)(n0 + n) * 2048 + koff + k0 + 8 * c8) = o; }
    __syncthreads();
}

__device__ __forceinline__ void phase1(const Params& P, unsigned char* smem, const int layer, const int cidx, const Chunk ck) {
    int tid_ = threadIdx.x; asm volatile("" : "+v"(tid_));
    const int tid = tid_, lane = tid & 63, wave = tid >> 6;
    if (cidx == 0) {
        float2* data = (float2*)smem; float2* tw = (float2*)(smem + FFT_DATA_BYTES); float* w3s = (float*)(smem + FFT_DATA_BYTES + 32768);
        fft_init_tw(tw, tid);
        const float* z2 = (const float*)(P.ws + OFF_Z2) + (size_t)layer * 4352 * 64;
        const float* w3 = P.in[I_HW3] + (size_t)layer * 64 * 2048;
        const float* dec = P.in[I_HDEC] + layer * 2048;
        const float* skp = P.in[I_HSKIP] + layer * 1024;
        for (int it = blockIdx.x; it < 1024; it += gridDim.x) {
            const int o = it >> 9, c = it & 511;
            __syncthreads();
            if (tid < 128) { const int d = tid >> 6, j = tid & 63; w3s[tid] = w3[j * 2048 + o * 1024 + d * 512 + c]; }
            __syncthreads();
            const float df = fabsf(dec[o * 1024 + c]), db = fabsf(dec[o * 1024 + 512 + c]), sk = skp[o * 512 + c];
#pragma unroll 1
            for (int i = 0; i < 8; ++i) { const int t = tid + 512 * i; const f32x4* zr = (const f32x4*)(z2 + (size_t)t * 64);
                float af = 0.f, ab = 0.f;
#pragma unroll
                for (int j4 = 0; j4 < 16; ++j4) { const f32x4 z = zr[j4];
#pragma unroll
                    for (int e = 0; e < 4; ++e) { af += z[e] * w3s[j4 * 4 + e]; ab += z[e] * w3s[64 + j4 * 4 + e]; } }
                const float tt = (float)t * (1.f / 4096.f);
                af *= expf(-df * tt); ab *= expf(-db * tt);
                if (t == 0) { data[0] = make_float2(af + sk, 0.f); data[PHYS(4096)] = make_float2(0.f, 0.f); }
                else { data[PHYS(t)] = make_float2(af, 0.f); data[PHYS(8192 - t)] = make_float2(ab, 0.f); } }
            __syncthreads();
            fft_fwd_hi(data, tw, true, tid);
            fft_mid<false>(data, nullptr, (float2*)(P.ws + OFF_SPECL) + (size_t)(o * 512 + c) * 8192, 1.f / 8192.f, 0, tid);
        }
        for (int it = blockIdx.x; it < 64; it += gridDim.x) {
            const int o = it >> 5, c0 = (it & 31) * 16;
            __syncthreads();
            const int q = tid >> 5, ts = tid & 31, c = c0 + q;
            const float df = fabsf(dec[o * 1024 + c]), db = fabsf(dec[o * 1024 + 512 + c]), sk = skp[o * 512 + c];
#pragma unroll 1
            for (int i = 0; i < 8; ++i) { const int t = ts + 32 * i; const float* zr = z2 + (size_t)(4096 + t) * 64;
                float af = 0.f, ab = 0.f;
#pragma unroll 4
                for (int j = 0; j < 64; ++j) { const float z = zr[j]; af += z * w3[j * 2048 + o * 1024 + c]; ab += z * w3[j * 2048 + o * 1024 + 512 + c]; }
                const float tt = (float)t * (1.f / 256.f);
                af *= expf(-df * tt); ab *= expf(-db * tt);
                if (t == 0) { data[PHYS(q * 512)] = make_float2(af + sk, 0.f); data[PHYS(q * 512 + 256)] = make_float2(0.f, 0.f); }
                else { data[PHYS(q * 512 + t)] = make_float2(af, 0.f); data[PHYS(q * 512 + 512 - t)] = make_float2(ab, 0.f); } }
            __syncthreads();
            fft_fwd_hi(data, tw, false, tid);
            fft_mid<false>(data, nullptr, (float2*)(P.ws + OFF_SPECS) + (size_t)(o * 512 + c0) * 512, 1.f / 512.f, 0, tid);
        }
        __syncthreads();
        float* s = (float*)smem;
        for (int it = blockIdx.x; it < 4352; it += gridDim.x) {
            int r = it;
            if (r < 3328) { transpose_item(P.in[I_WIN] + (size_t)layer * 2048 * INW, INW, (bf16_t*)(P.ws + OFF_WTIN), 0, r, s, tid); continue; } r -= 3328;
            if (r < 512) { transpose_item(P.in[I_WOUT] + (size_t)layer * 2048 * 2048, 2048, (bf16_t*)(P.ws + OFF_WTOUT), 0, r, s, tid); continue; } r -= 512;
            if (r < 192) { transpose_item(P.in[I_WUA] + (size_t)layer * 768 * 2048, 2048, (bf16_t*)(P.ws + OFF_WTUP), 0, r, s, tid); continue; } r -= 192;
            if (r < 128) { transpose_item(P.in[I_WUB] + (size_t)layer * 512 * 2048, 2048, (bf16_t*)(P.ws + OFF_WTUP), 768, r, s, tid); continue; } r -= 128;
            transpose_item(P.in[I_WUC] + (size_t)layer * 768 * 2048, 2048, (bf16_t*)(P.ws + OFF_WTUP), 1280, r, s, tid);
        }
    }
    const float* nw = P.in[I_NW] + layer * D;
    for (int it = blockIdx.x; it < ck.ntok / 64; it += gridDim.x) {
#pragma unroll 1
        for (int i = 0; i < 8; ++i) {
            const int r = it * 64 + wave * 8 + i, g = ck.tok0 + r;
            const float* x = (layer == 0) ? (g < NCTXTOK ? P.in[I_XP] + (size_t)g * D : P.in[I_XS] + (size_t)(g - NCTXTOK) * D) : P.out + (size_t)g * D;
            const float* md = (const float*)(P.ws + OFF_MOD) + ((size_t)layer * 9 + cond_of(g)) * 6144;
            f32x4 v[8]; float ss = 0.f;
#pragma unroll
            for (int j = 0; j < 8; ++j) { v[j] = *(const f32x4*)(x + lane * 4 + 256 * j); ss += v[j][0] * v[j][0] + v[j][1] * v[j][1] + v[j][2] * v[j][2] + v[j][3] * v[j][3]; }
            const float rstd = rsqrtf(wave_sum(ss) * (1.f / D) + 1e-6f);
            bf16_t* h = (bf16_t*)(P.ws + OFF_H) + (size_t)r * D;
#pragma unroll
            for (int j = 0; j < 8; ++j) { const int k = lane * 4 + 256 * j; const f32x4 w = *(const f32x4*)(nw + k), sh = *(const f32x4*)(md + k), sc = *(const f32x4*)(md + 2048 + k);
                f32x4 y;
#pragma unroll
                for (int e = 0; e < 4; ++e) y[e] = v[j][e] * rstd * w[e] * (1.f + sc[e]) + sh[e];
                u32x2 o; o.x = cvt_pk_bf16(y[0], y[1]); o.y = cvt_pk_bf16(y[2], y[3]); *(u32x2*)(h + k) = o; }
        }
    }
}

__device__ __forceinline__ void hy_transpose_item(const Params& P, float* s, const int layer, const Chunk ck, int item, int tid) {
    const int tb = item >> 5, cb = item & 31, t0 = tb * 64;
    const int ctxrows = ck.nctxb * 256;
    const int Ls = (t0 < ctxrows) ? 256 : 4096; const int tin = (t0 < ctxrows) ? (t0 & 255) : ((t0 - ck.lat_row0) & 4095);
    const bool first = (tin == 0), lastb = (tin + 64 == Ls);
    const bf16_t* U = (const bf16_t*)(P.ws + OFF_U7);
    for (int idx = tid; idx < 66 * 8; idx += NTHREADS) { const int rr = idx >> 3, ch = idx & 7;
        const bool valid = !((rr == 0 && first) || (rr == 65 && lastb));
        u32x4 w = (u32x4){0u, 0u, 0u, 0u};
        if (valid) w = *(const u32x4*)(U + (size_t)(t0 - 1 + rr) * U7W + 2048 + cb * 64 + ch * 8);
        float* d = s + rr * 65 + ch * 8; d[0] = bf_lo(w.x); d[1] = bf_hi(w.x); d[2] = bf_lo(w.y); d[3] = bf_hi(w.y); d[4] = bf_lo(w.z); d[5] = bf_hi(w.z); d[6] = bf_lo(w.w); d[7] = bf_hi(w.w); }
    __syncthreads();
    const int col = tid >> 3, tch = tid & 7, cc = cb * 64 + col;
    float o[8];
    if (cb < 24) { const float* cw = P.in[I_HCW] + (size_t)layer * 3 * 1536; const float w0 = cw[cc], w1 = cw[1536 + cc], w2 = cw[3072 + cc], bb = P.in[I_HCB][layer * 1536 + cc];
#pragma unroll
        for (int i = 0; i < 8; ++i) { const int t = tch * 8 + i; o[i] = bb + w0 * s[t * 65 + col] + w1 * s[(t + 1) * 65 + col] + w2 * s[(t + 2) * 65 + col]; } }
    else {
#pragma unroll
        for (int i = 0; i < 8; ++i) { const int t = tch * 8 + i; o[i] = s[(t + 1) * 65 + col]; } }
    u32x4 w; w.x = cvt_pk_bf16(o[0], o[1]); w.y = cvt_pk_bf16(o[2], o[3]); w.z = cvt_pk_bf16(o[4], o[5]); w.w = cvt_pk_bf16(o[6], o[7]);
    *(u32x4*)((bf16_t*)(P.ws + OFF_H) + (size_t)cc * ck.ntok + t0 + tch * 8) = w;
    __syncthreads();
}

typedef short s16x4 __attribute__((ext_vector_type(4)));
__device__ __forceinline__ void attn_item(const Params& P, unsigned char* smem, const int layer, const Chunk ck, int kind, int b, int h, int qb) {
    int tid_ = threadIdx.x; asm volatile("" : "+v"(tid_));
    const int tid = tid_, lane = tid & 63, wave = tid >> 6, fr = lane & 15, fq = lane >> 4;
    bf16_t* KV = (bf16_t*)smem;
    float* rpbs = (float*)(smem + 4 * 64 * 72 * 2);
    bf16_t* U = (bf16_t*)(P.ws + OFF_U7);
    const bool lat = kind < 2, isA = (kind == 0 || kind == 2);
    const int seq_row0 = lat ? ck.lat_row0 + (b - ck.latb0) * 4096 : b * 256;
    const int q0 = qb * 128;
    const int kh = isA ? h / 3 : h;
    const int qcol = isA ? h * 64 : 4096 + h * 64, kcol = isA ? 768 + kh * 64 : 4864 + h * 64, vcol = isA ? 1024 + kh * 64 : 5632 + h * 64, gcol = isA ? 1280 + h * 64 : 6400 + h * 64;
    int lt0, nlt;
    if (kind == 0) { const int a = q0 - 128 < 0 ? 0 : q0 - 128, e = q0 + 256 > 4096 ? 4096 : q0 + 256; lt0 = a; nlt = (e - a) >> 6; }
    else if (kind == 1) { const int r0 = q0 >> 6; int rs0 = r0 - 4; rs0 = rs0 < 0 ? 0 : (rs0 > 56 ? 56 : rs0); int rs1 = r0 - 3; rs1 = rs1 < 0 ? 0 : (rs1 > 56 ? 56 : rs1); lt0 = rs0 * 64; nlt = rs1 + 8 - rs0; }
    else { lt0 = 0; nlt = 4; }
    const int nct = lat ? 8 : 0, ntiles = nct + nlt;
    const float* cK = isA ? P.in[I_CAK] : P.in[I_CCK]; const float* cV = isA ? P.in[I_CAV] : P.in[I_CCV]; const int HK = isA ? 4 : 12;
    const float2* rope = (const float2*)(P.ws + OFF_ROPE);
    const int qrow = q0 + wave * 16 + fr;
    const int skey = tid >> 3, spc = tid & 7;
    u32x4 raw[4];
#define ATT_ISSUE(ti_) do { if ((ti_) < nct) { \
            const size_t off_ = ((((size_t)b * 2 + layer) * PAST + (size_t)(ti_) * 64 + skey) * HK + kh) * 64 + spc * 8; \
            raw[0] = *(const u32x4*)(cK + off_); raw[1] = *(const u32x4*)(cK + off_ + 4); raw[2] = *(const u32x4*)(cV + off_); raw[3] = *(const u32x4*)(cV + off_ + 4); \
        } else { const int tok_ = lt0 + ((ti_) - nct) * 64 + skey; const bf16_t* rowp_ = U + (size_t)(seq_row0 + tok_) * U7W; \
            raw[0] = *(const u32x4*)(rowp_ + kcol + spc * 8); raw[1] = *(const u32x4*)(rowp_ + vcol + spc * 8); \
            if (kind == 0) raw[2] = *(const u32x4*)(rowp_ + kcol + (spc ^ 4) * 8); } } while (0)
    __syncthreads();
    ATT_ISSUE(0);
    if (kind == 1) { for (int i = tid; i < 465; i += NTHREADS) rpbs[i] = P.in[I_RPB][((size_t)layer * 12 + h) * 465 + i]; }
    bf16x8 qf[2];
    {
        const bf16_t* qp = U + (size_t)(seq_row0 + qrow) * U7W + qcol + fq * 8;
        u32x4 a0 = *(const u32x4*)qp, a1 = *(const u32x4*)(qp + 32);
        if (kind == 0) {
            const int rr = qrow >> 6, cc = qrow & 63;
            float x1[8], x2[8];
#pragma unroll
            for (int e = 0; e < 4; ++e) { x1[2 * e] = bf_lo(a0[e]); x1[2 * e + 1] = bf_hi(a0[e]); x2[2 * e] = bf_lo(a1[e]); x2[2 * e + 1] = bf_hi(a1[e]); }
#pragma unroll
            for (int j = 0; j < 8; ++j) { const int i = fq * 8 + j; const float2 cs = (i < 16) ? rope[rr * 16 + i] : rope[cc * 16 + i - 16];
                const float o1 = x1[j] * cs.x - x2[j] * cs.y, o2 = x1[j] * cs.y + x2[j] * cs.x; x1[j] = o1; x2[j] = o2; }
#pragma unroll
            for (int e = 0; e < 4; ++e) { a0[e] = cvt_pk_bf16(x1[2 * e], x1[2 * e + 1]); a1[e] = cvt_pk_bf16(x2[2 * e], x2[2 * e + 1]); }
        }
        qf[0] = __builtin_bit_cast(bf16x8, a0); qf[1] = __builtin_bit_cast(bf16x8, a1);
    }
    float mrun, lsum;
    if (isA) { mrun = P.in[I_SINK][layer * 12 + h]; lsum = (fq == 0) ? 1.f : 0.f; } else { mrun = -1e30f; lsum = 0.f; }
    f32x4 o[4];
#pragma unroll
    for (int dt = 0; dt < 4; ++dt) o[dt] = (f32x4){0.f, 0.f, 0.f, 0.f};
    for (int ti = 0; ti < ntiles; ++ti) {
        bf16_t* Ks = KV + (ti & 1) * (2 * 64 * 72); bf16_t* Vs = Ks + 64 * 72;
        {
            u32x4 kw, vw;
            if (ti < nct) {
                const f32x4 k0 = __builtin_bit_cast(f32x4, raw[0]), k1 = __builtin_bit_cast(f32x4, raw[1]), v0 = __builtin_bit_cast(f32x4, raw[2]), v1 = __builtin_bit_cast(f32x4, raw[3]);
                kw.x = cvt_pk_bf16(k0[0], k0[1]); kw.y = cvt_pk_bf16(k0[2], k0[3]); kw.z = cvt_pk_bf16(k1[0], k1[1]); kw.w = cvt_pk_bf16(k1[2], k1[3]);
                vw.x = cvt_pk_bf16(v0[0], v0[1]); vw.y = cvt_pk_bf16(v0[2], v0[3]); vw.z = cvt_pk_bf16(v1[0], v1[1]); vw.w = cvt_pk_bf16(v1[2], v1[3]);
            } else {
                kw = raw[0]; vw = raw[1];
                if (kind == 0) {
                    const u32x4 pw = raw[2];
                    const int tok = lt0 + (ti - nct) * 64 + skey;
                    const int rr = tok >> 6, cc = tok & 63; const bool lo = spc < 4;
#pragma unroll
                    for (int e = 0; e < 4; ++e) {
                        float r2[2];
#pragma unroll
                        for (int hh = 0; hh < 2; ++hh) { const int i = (spc & 3) * 8 + 2 * e + hh; const float2 cs = (i < 16) ? rope[rr * 16 + i] : rope[cc * 16 + i - 16];
                            const float mine = hh ? bf_hi(kw[e]) : bf_lo(kw[e]), oth = hh ? bf_hi(pw[e]) : bf_lo(pw[e]);
                            r2[hh] = lo ? (mine * cs.x - oth * cs.y) : (oth * cs.y + mine * cs.x); }
                        kw[e] = cvt_pk_bf16(r2[0], r2[1]); }
                }
            }
            *(u32x4*)(Ks + skey * 72 + spc * 8) = kw;
            *(u32x4*)(Vs + skey * 72 + spc * 8) = vw;
        }
        __syncthreads();
        if (ti + 1 < ntiles) ATT_ISSUE(ti + 1);
        f32x4 sc[4];
#pragma unroll
        for (int st = 0; st < 4; ++st) { sc[st] = (f32x4){0.f, 0.f, 0.f, 0.f};
#pragma unroll
            for (int ks = 0; ks < 2; ++ks) { const bf16x8 a = *(const bf16x8*)(Ks + (st * 16 + fr) * 72 + ks * 32 + fq * 8); sc[st] = __builtin_amdgcn_mfma_f32_16x16x32_bf16(a, qf[ks], sc[st], 0, 0, 0); } }
        float mx = mrun;
        const bool local = ti >= nct; const int ttok0 = lt0 + (ti - nct) * 64;
#pragma unroll
        for (int st = 0; st < 4; ++st)
#pragma unroll
            for (int i = 0; i < 4; ++i) { float sv = sc[st][i] * 0.125f; const int kk = st * 16 + fq * 4 + i;
                if (local && kind == 0) { const int d = qrow - (ttok0 + kk); if (d > 128 || d < -128) sv = -1e30f; }
                if (local && kind == 1) { const int kr = ttok0 >> 6, r = qrow >> 6, w = qrow & 63; int rs = r - 4; rs = rs < 0 ? 0 : (rs > 56 ? 56 : rs); int cs = w - 8; cs = cs < 0 ? 0 : (cs > 48 ? 48 : cs);
                    const bool ok = (kr >= rs) && (kr < rs + 8) && (kk >= cs) && (kk < cs + 16);
                    const int bi = ok ? (kr - r + 7) * 31 + (kk - w + 15) : 0; const float bias = rpbs[bi]; sv = ok ? sv + bias : -1e30f; }
                sc[st][i] = sv; mx = fmaxf(mx, sv); }
        mx = fmaxf(mx, __shfl_xor(mx, 16)); mx = fmaxf(mx, __shfl_xor(mx, 32));
        const float alpha = __expf(mrun - mx); mrun = mx; lsum *= alpha;
#pragma unroll
        for (int dt = 0; dt < 4; ++dt) o[dt] *= alpha;
#pragma unroll
        for (int st = 0; st < 4; ++st)
#pragma unroll
            for (int i = 0; i < 4; ++i) { const float p = __expf(sc[st][i] - mx); lsum += p; sc[st][i] = p; }
#pragma unroll
        for (int k2 = 0; k2 < 2; ++k2) {
            u32x4 pw; pw.x = cvt_pk_bf16(sc[2 * k2][0], sc[2 * k2][1]); pw.y = cvt_pk_bf16(sc[2 * k2][2], sc[2 * k2][3]); pw.z = cvt_pk_bf16(sc[2 * k2 + 1][0], sc[2 * k2 + 1][1]); pw.w = cvt_pk_bf16(sc[2 * k2 + 1][2], sc[2 * k2 + 1][3]);
            const bf16x8 pb = __builtin_bit_cast(bf16x8, pw);
#pragma unroll
            for (int dt = 0; dt < 4; ++dt) { const bf16_t* vp = Vs + (32 * k2 + fq * 4 + (fr >> 2)) * 72 + dt * 16 + 4 * (fr & 3);
                const s16x4 v0 = __builtin_amdgcn_ds_read_tr16_b64_v4i16((LAS s16x4*)vp), v1 = __builtin_amdgcn_ds_read_tr16_b64_v4i16((LAS s16x4*)(vp + 16 * 72));
                bf16x8 aw; aw[0] = v0[0]; aw[1] = v0[1]; aw[2] = v0[2]; aw[3] = v0[3]; aw[4] = v1[0]; aw[5] = v1[1]; aw[6] = v1[2]; aw[7] = v1[3];
                o[dt] = __builtin_amdgcn_mfma_f32_16x16x32_bf16(aw, pb, o[dt], 0, 0, 0); }
        }
    }
#undef ATT_ISSUE
    lsum += __shfl_xor(lsum, 16); lsum += __shfl_xor(lsum, 32);
    const float inv = 1.f / lsum;
    bf16_t* gp = U + (size_t)(seq_row0 + qrow) * U7W + gcol + fq * 4;
#pragma unroll
    for (int dt = 0; dt < 4; ++dt) { const u32x2 gw = *(const u32x2*)(gp + dt * 16);
        const float g0 = bf_lo(gw.x), g1 = bf_hi(gw.x), g2 = bf_lo(gw.y), g3 = bf_hi(gw.y);
        u32x2 ow; ow.x = cvt_pk_bf16(o[dt][0] * inv * g0 * sigmoidf_(g0), o[dt][1] * inv * g1 * sigmoidf_(g1)); ow.y = cvt_pk_bf16(o[dt][2] * inv * g2 * sigmoidf_(g2), o[dt][3] * inv * g3 * sigmoidf_(g3));
        *(u32x2*)(gp + dt * 16) = ow; }
}

__device__ __forceinline__ void phase3a(const Params& P, unsigned char* smem, const int layer, const Chunk ck) {
    int tid_ = threadIdx.x; asm volatile("" : "+v"(tid_));
    const int tid = tid_;
    const int n_latA = ck.nlatb * 12 * 32, n_ctxA = ck.nctxb * 12 * 2;
    const int n_attn = 2 * n_latA + 2 * n_ctxA;
    const int n_tr = (ck.ntok / 64) * 32;
    for (int it = blockIdx.x; it < n_attn + n_tr; it += gridDim.x) {
        if (it < n_attn) {
            int r = it, kind, b, h, qb;
            if (r < 2 * n_latA) { kind = r / n_latA; r -= kind * n_latA; b = ck.latb0 + r / 384; r %= 384; h = r / 32; qb = r % 32; }
            else { r -= 2 * n_latA; kind = 2 + r / n_ctxA; r %= n_ctxA; b = r / 24; r %= 24; h = r >> 1; qb = r & 1; }
            attn_item(P, smem, layer, ck, kind, b, h, qb);
        } else {
            __syncthreads();
            hy_transpose_item(P, (float*)smem, layer, ck, it - n_attn, tid);
        }
    }
}

__device__ __forceinline__ void phase3b(const Params& P, unsigned char* smem, const int layer, const Chunk ck) {
    int tid_ = threadIdx.x; asm volatile("" : "+v"(tid_));
    const int tid = tid_;
    float2* data = (float2*)smem; float2* tw = (float2*)(smem + FFT_DATA_BYTES);
    fft_init_tw(tw, tid);
    const bf16_t* T = (const bf16_t*)(P.ws + OFF_H);
    bf16_t* U = (bf16_t*)(P.ws + OFF_U7);
    const int npair = ck.nlatb / 2, nlat_items = npair * 512, nctx_items = ck.nctxb ? 512 : 0;
    const size_t nt = (size_t)ck.ntok;
    for (int it = blockIdx.x; it < nlat_items + nctx_items; it += gridDim.x) {
        const bool lat = it < nlat_items;
        const int c = lat ? (it & 511) : ((it - nlat_items) & 511);
        const int pr = lat ? (it >> 9) : 0;
        const bf16_t* tv = T + (size_t)c * nt; const bf16_t* tx1 = T + (size_t)(512 + c) * nt; const bf16_t* tx2 = T + (size_t)(1024 + c) * nt; const bf16_t* tg = T + (size_t)(1536 + c) * nt;
        const float2* sp0 = lat ? (const float2*)(P.ws + OFF_SPECL) + (size_t)c * 8192 : (const float2*)(P.ws + OFF_SPECS) + (size_t)c * 512;
        const float2* sp1 = lat ? sp0 + (size_t)512 * 8192 : sp0 + (size_t)512 * 512;
        const int spmask = lat ? 8191 : 511;
        __syncthreads();
#define HY_MAP(idx, valid, rA, rB) do { if (lat) { valid = (idx) < 4096; rA = ck.lat_row0 + pr * 8192 + (idx); rB = rA + 4096; } \
                                        else { const int q_ = (idx) >> 9, t_ = (idx) & 511; valid = t_ < 256; rA = q_ * 512 + t_; rB = rA + 256; } } while (0)
#pragma unroll
        for (int i = 0; i < 2; ++i) { const int idx = (tid + 512 * i) * 8; bool valid; int rA, rB; HY_MAP(idx, valid, rA, rB);
            float2* dp = data + PHYS(idx);
            if (valid) { const u32x4 a = *(const u32x4*)(tv + rA), bq = *(const u32x4*)(tv + rB);
#pragma unroll
                for (int e = 0; e < 4; ++e) { dp[2 * e] = make_float2(bf_lo(a[e]), bf_lo(bq[e])); dp[2 * e + 1] = make_float2(bf_hi(a[e]), bf_hi(bq[e])); } }
            else {
#pragma unroll
                for (int e = 0; e < 8; ++e) dp[e] = make_float2(0.f, 0.f); } }
        __syncthreads();
        fft_fwd_hi(data, tw, lat, tid);
        fft_mid<true>(data, sp0, nullptr, 1.f, spmask, tid);
        fft_inv_hi(data, tw, lat, tid);
#pragma unroll
        for (int i = 0; i < 2; ++i) { const int idx = (tid + 512 * i) * 8; bool valid; int rA, rB; HY_MAP(idx, valid, rA, rB);
            float2* dp = data + PHYS(idx);
            if (valid) { const u32x4 a = *(const u32x4*)(tx1 + rA), bq = *(const u32x4*)(tx1 + rB);
#pragma unroll
                for (int e = 0; e < 4; ++e) { float2 v0 = dp[2 * e], v1 = dp[2 * e + 1]; dp[2 * e] = make_float2(v0.x * bf_lo(a[e]), v0.y * bf_lo(bq[e])); dp[2 * e + 1] = make_float2(v1.x * bf_hi(a[e]), v1.y * bf_hi(bq[e])); } }
            else {
#pragma unroll
                for (int e = 0; e < 8; ++e) dp[e] = make_float2(0.f, 0.f); } }
        __syncthreads();
        fft_fwd_hi(data, tw, lat, tid);
        fft_mid<true>(data, sp1, nullptr, 1.f, spmask, tid);
        fft_inv_hi(data, tw, lat, tid);
#pragma unroll
        for (int i = 0; i < 2; ++i) { const int idx = (tid + 512 * i) * 8; bool valid; int rA, rB; HY_MAP(idx, valid, rA, rB);
            const float2* dp = data + PHYS(idx);
            if (valid) { const u32x4 xa = *(const u32x4*)(tx2 + rA), xb = *(const u32x4*)(tx2 + rB), ga = *(const u32x4*)(tg + rA), gb = *(const u32x4*)(tg + rB);
#pragma unroll
                for (int e = 0; e < 8; ++e) { const float2 v = dp[e];
                    const float x2a = (e & 1) ? bf_hi(xa[e >> 1]) : bf_lo(xa[e >> 1]), x2b = (e & 1) ? bf_hi(xb[e >> 1]) : bf_lo(xb[e >> 1]);
                    const float gA = (e & 1) ? bf_hi(ga[e >> 1]) : bf_lo(ga[e >> 1]), gB = (e & 1) ? bf_hi(gb[e >> 1]) : bf_lo(gb[e >> 1]);
                    U[(size_t)(rA + e) * U7W + 3584 + c] = f2bf(v.x * x2a * gA * sigmoidf_(gA));
                    U[(size_t)(rB + e) * U7W + 3584 + c] = f2bf(v.y * x2b * gB * sigmoidf_(gB)); } } }
#undef HY_MAP
    }
}

__device__ __forceinline__ void phase_final(const Params& P) {
    int tid_ = threadIdx.x; asm volatile("" : "+v"(tid_));
    const int tid = tid_, lane = tid & 63, wave = tid >> 6;
    const float* fw = P.in[I_FNW];
    for (int it = blockIdx.x; it < 40960 / 8; it += gridDim.x) {
        const int g = it * 8 + wave; float* x = P.out + (size_t)g * D;
        f32x4 v[8]; float ss = 0.f;
#pragma unroll
        for (int j = 0; j < 8; ++j) { v[j] = *(const f32x4*)(x + lane * 4 + 256 * j); ss += v[j][0] * v[j][0] + v[j][1] * v[j][1] + v[j][2] * v[j][2] + v[j][3] * v[j][3]; }
        const float rstd = rsqrtf(wave_sum(ss) * (1.f / D) + 1e-6f);
#pragma unroll
        for (int j = 0; j < 8; ++j) { const int k = lane * 4 + 256 * j; const f32x4 w = *(const f32x4*)(fw + k); *(f32x4*)(x + k) = v[j] * rstd * w; }
    }
}

__global__ void __launch_bounds__(NTHREADS, 2) fwd_megakernel(Params P) {
    extern __shared__ __attribute__((aligned(16))) unsigned char smem[];
    cg::grid_group grid = cg::this_grid();
#ifndef PMASK
#define PMASK 0xff
#endif
    if (PMASK & 1) phase0(P, smem);
    grid.sync();
    for (int layer = 0; layer < 2; ++layer) {
        for (int c = 0; c < 2; ++c) {
            const Chunk ck = get_chunk(c);
            if (PMASK & 2) phase1(P, smem, layer, c, ck);
            grid.sync();
            if (PMASK & 4) gemm_phase<2>((LAS unsigned char*)smem, P, layer, ck);
            grid.sync();
            if (PMASK & 8) phase3a(P, smem, layer, ck);
            grid.sync();
            if (PMASK & 16) phase3b(P, smem, layer, ck);
            grid.sync();
            if (PMASK & 32) gemm_phase<4>((LAS unsigned char*)smem, P, layer, ck);
            grid.sync();
            if (PMASK & 64) gemm_phase<5>((LAS unsigned char*)smem, P, layer, ck);
            grid.sync();
        }
    }
    if (PMASK & 128) phase_final(P);
}

extern "C" void kernel_launch(void* const* d_in, const int* in_sizes, int n_in, void* d_out, int out_size, void* d_ws, size_t ws_size, hipStream_t stream) {
    static int grid_blocks = 0;
    if (grid_blocks == 0) {
        if (n_in != 29 || ws_size < WS_END) { fprintf(stderr, "kernel_launch: need 29 inputs and %zu bytes of workspace (got %d, %zu)\n", (size_t)WS_END, n_in, ws_size); grid_blocks = -1; return; }
        int dev = 0, cus = 0, per_cu = 0;
        hipGetDevice(&dev);
        hipDeviceGetAttribute(&cus, hipDeviceAttributeMultiprocessorCount, dev);
        if (hipFuncSetAttribute((const void*)fwd_megakernel, hipFuncAttributeMaxDynamicSharedMemorySize, LDS_BYTES) != hipSuccess) { fprintf(stderr, "kernel_launch: hipFuncSetAttribute failed\n"); grid_blocks = -1; return; }
        hipOccupancyMaxActiveBlocksPerMultiprocessor(&per_cu, (const void*)fwd_megakernel, NTHREADS, LDS_BYTES);
        if (per_cu < 1) per_cu = 1;
        grid_blocks = cus * per_cu;
        (void)hipGetLastError();
    }
    if (grid_blocks < 0) return;
    Params p{};
    for (int i = 0; i < 29; ++i) p.in[i] = (const float*)d_in[i];
    p.out = (float*)d_out; p.ws = (unsigned char*)d_ws;
    void* args[] = {&p};
    hipError_t e = hipLaunchCooperativeKernel((const void*)fwd_megakernel, dim3(grid_blocks), dim3(NTHREADS), args, LDS_BYTES, stream);
    if (e != hipSuccess) fprintf(stderr, "cooperative launch failed: %s (grid %d)\n", hipGetErrorString(e), grid_blocks);
}
```

```cpp
#include <hip/hip_runtime.h>
#include <hip/hip_cooperative_groups.h>
#include <cstdio>
#include <cstdint>
namespace cg = cooperative_groups;

#define LAS __attribute__((address_space(3)))
typedef unsigned short bf16_t;
typedef short bf16x8 __attribute__((ext_vector_type(8)));
typedef float f32x4 __attribute__((ext_vector_type(4)));
typedef unsigned u32x4 __attribute__((ext_vector_type(4)));
typedef unsigned u32x2 __attribute__((ext_vector_type(2)));

constexpr int D = 2048, NCTXTOK = 8192, LLAT = 4096, LCTX = 256, PAST = 512;
constexpr int INW = 13312, U7W = 7168, MGW = 6144;
constexpr int NTHREADS = 512;
constexpr int LDS_BYTES = 131072;
constexpr size_t OUT_AK = 83886080ull, OUT_AV = 88080384ull, OUT_CK = 92274688ull, OUT_CV = 104857600ull;
constexpr size_t OFF_MOD = 4096;
constexpr size_t OFF_ROPE = OFF_MOD + 2ull * 9 * 6144 * 4;
constexpr size_t OFF_Z2 = OFF_ROPE + 8192;
constexpr size_t OFF_WTIN = OFF_Z2 + 2ull * 4352 * 64 * 4;
constexpr size_t OFF_WTUP = OFF_WTIN + 13312ull * 2048 * 2;
constexpr size_t OFF_WTOUT = OFF_WTUP + 2048ull * 2048 * 2;
constexpr size_t OFF_SPECL = OFF_WTOUT + 2048ull * 2048 * 2;
constexpr size_t OFF_SPECS = OFF_SPECL + 2ull * 512 * 8192 * 8;
constexpr size_t OFF_H = OFF_SPECS + 2ull * 512 * 512 * 8;
constexpr size_t OFF_U7 = OFF_H + 24576ull * 2048 * 2;
constexpr size_t OFF_MG = OFF_U7 + 24576ull * 7168 * 2;
constexpr size_t WS_END = OFF_MG + 24576ull * 6144 * 2;

struct Params { const float* in[29]; float* out; unsigned char* ws; };
enum { I_XP = 0, I_XS, I_C, I_CAK, I_CAV, I_CCK, I_CCV, I_CCTX, I_NW, I_WADA, I_BADA, I_WIN, I_SINK, I_HCW, I_HCB, I_HW1, I_HB1, I_HW2, I_HB2,
       I_HFREQ, I_HW3, I_HDEC, I_HSKIP, I_RPB, I_WUA, I_WUB, I_WUC, I_WOUT, I_FNW };

struct Chunk { int tok0, ntok, nctxb, lat_row0, latb0, nlatb; };
__device__ __forceinline__ Chunk get_chunk(int c) { Chunk k; if (c == 0) { k.tok0 = 0; k.ntok = 24576; k.nctxb = 32; k.lat_row0 = 8192; k.latb0 = 0; k.nlatb = 4; } else { k.tok0 = 24576; k.ntok = 16384; k.nctxb = 0; k.lat_row0 = 0; k.latb0 = 4; k.nlatb = 4; } return k; }
__device__ __forceinline__ int cond_of(int g) { return g < NCTXTOK ? 0 : 1 + ((g - NCTXTOK) >> 12); }

__device__ __forceinline__ unsigned cvt_pk_bf16(float lo, float hi) { unsigned r; asm volatile("v_cvt_pk_bf16_f32 %0, %1, %2" : "=v"(r) : "v"(lo), "v"(hi)); return r; }
__device__ __forceinline__ float bf_lo(unsigned u) { return __uint_as_float(u << 16); }
__device__ __forceinline__ float bf_hi(unsigned u) { return __uint_as_float(u & 0xffff0000u); }
__device__ __forceinline__ float bf2f(bf16_t b) { return __uint_as_float(((unsigned)b) << 16); }
__device__ __forceinline__ bf16_t f2bf(float f) { return (bf16_t)(cvt_pk_bf16(f, 0.f) & 0xffffu); }
__device__ __forceinline__ float wave_sum(float v) {
#pragma unroll
    for (int o = 1; o < 64; o <<= 1) v += __shfl_xor(v, o);
    return v;
}
__device__ __forceinline__ float sigmoidf_(float x) { return 1.f / (1.f + __expf(-x)); }

constexpr int BM = 256, BK = 64, HALF = 128, HTB = HALF * BK * 2;
__device__ __forceinline__ int lds_byte(int r, int c) { const int st = (r >> 4) * 2 + (c >> 5), rr = r & 15, cc = c & 31, ob = rr * 64 + cc * 2; return st * 1024 + (ob ^ (((ob >> 9) & 1) << 5)); }
__device__ __forceinline__ void stage_rc(int b, int& R, int& C) { const int st = b / 1024, sb = b % 1024, swz = sb ^ (((sb >> 9) & 1) << 5); R = (st >> 1) * 16 + swz / 64; C = (st & 1) * 32 + (swz % 64) / 2; }
__device__ __forceinline__ int perm32(int rho) { const int n = rho >> 4, i = rho & 15; return 8 * (i >> 2) + 4 * n + (i & 3); }

struct GSched { int nM, nN, ntile, G, c; };
template <int PER>
__device__ __forceinline__ bool gs_next(const GSched& S, int ui, int& pm, int& pn, int& br) {
    const int round = ui / PER; br = ui - round * PER;
    const long L = (long)round * S.G + S.c; if (L >= S.ntile) return false;
    int wgid = (int)L; { const int q = S.ntile / 8, r = S.ntile % 8, xcd = wgid % 8, off = wgid / 8; wgid = (xcd < r ? xcd * (q + 1) : r * (q + 1) + (xcd - r) * q) + off; }
    const int nig = 8 * S.nN, gid = wgid / nig, fm = gid * 8, gsz = (S.nM - fm) < 8 ? (S.nM - fm) : 8;
    pm = fm + ((wgid % nig) % gsz); pn = (wgid % nig) / gsz; return true;
}

template <int MODE>
__device__ __forceinline__ void gemm_phase(LAS unsigned char* lds, const Params& P, const int layer, const Chunk ck) {
    constexpr bool PERM = (MODE != 5);
    constexpr int PER = (MODE == 4) ? 3 : 1;
    int tid_ = threadIdx.x; asm volatile("" : "+v"(tid_));
    const int tid = tid_, wid = __builtin_amdgcn_readfirstlane(tid >> 6), lane = tid & 63, wr = wid >> 2, wc = wid & 3, fr = lane & 15, fq = lane >> 4;
    const char* Abase; const char* Bbase; unsigned lda, ldb; int nN;
    if (MODE == 2) { Abase = (const char*)(P.ws + OFF_H); lda = 4096u; Bbase = (const char*)(P.ws + OFF_WTIN); ldb = 4096u; nN = 52; }
    else if (MODE == 4) { Abase = (const char*)(P.ws + OFF_U7); lda = 14336u; Bbase = (const char*)(P.ws + OFF_WTUP); ldb = 4096u; nN = 8; }
    else { Abase = (const char*)(P.ws + OFF_H); lda = 4096u; Bbase = (const char*)(P.ws + OFF_WTOUT); ldb = 4096u; nN = 8; }
    GSched S; S.nM = ck.ntok / 256; S.nN = nN; S.ntile = S.nM * nN; S.G = (int)gridDim.x; S.c = (int)blockIdx.x;
    unsigned voffA[2], voffB[2];
#pragma unroll
    for (int i = 0; i < 2; ++i) { int R, C; stage_rc(tid * 16 + i * 8192, R, C); const int Rb = PERM ? ((R & ~31) + perm32(R & 31)) : R;
        voffA[i] = (unsigned)R * lda + (unsigned)C * 2u; voffB[i] = (unsigned)Rb * ldb + (unsigned)C * 2u; }
    const size_t kstep = (size_t)(BK * 2);
    const size_t hstepA = (size_t)HALF * lda, hstepB = (size_t)HALF * ldb;
    const unsigned ldsw = (unsigned)wid * 1024u;
    const int aoff = lds_byte(wr * 64 + fr, fq * 8), boff = lds_byte(wc * 32 + fr, fq * 8);
#define PG8_SA(b, h) (((b) * 2 + (h)) * HTB)
#define PG8_SB(b, h) ((4 + (b) * 2 + (h)) * HTB)
#define PG8_STAGE(bufoff, gbase, voff) do { _Pragma("unroll") for (int _i = 0; _i < 2; ++_i) \
        __builtin_amdgcn_global_load_lds((const unsigned*)((const char*)(gbase) + (voff)[_i]), (LAS unsigned*)(lds + (bufoff) + ldsw + _i * 8192), 16, 0, 0); } while (0)
#define PG8_LDA(dst, b, h) do { _Pragma("unroll") for (int m = 0; m < 4; ++m) _Pragma("unroll") for (int k = 0; k < 2; ++k) dst[m][k] = *(const LAS bf16x8*)(lds + PG8_SA(b, h) + aoff + m * 2048 + k * 1024); } while (0)
#define PG8_LDB(dst, b, h) do { _Pragma("unroll") for (int n = 0; n < 2; ++n) _Pragma("unroll") for (int k = 0; k < 2; ++k) dst[n][k] = *(const LAS bf16x8*)(lds + PG8_SB(b, h) + boff + n * 2048 + k * 1024); } while (0)
#define PG8_MMA(ai, bj, At, Bt) do { __builtin_amdgcn_s_setprio(1); _Pragma("unroll") for (int m = 0; m < 4; ++m) _Pragma("unroll") for (int n = 0; n < 2; ++n) _Pragma("unroll") for (int k = 0; k < 2; ++k) \
        acc[ai][bj][m][n] = __builtin_amdgcn_mfma_f32_16x16x32_bf16(Bt[n][k], At[m][k], acc[ai][bj][m][n], 0, 0, 0); __builtin_amdgcn_s_setprio(0); } while (0)
#define PG8_WAIT_V(n) asm volatile("s_waitcnt vmcnt(" #n ")" ::: "memory")
#define PG8_WAIT_L(n) asm volatile("s_waitcnt lgkmcnt(" #n ")" ::: "memory")
#define PG8_BAR __builtin_amdgcn_s_barrier()
#define PG8_SCHED __builtin_amdgcn_sched_barrier(0)
#define UNIT_PTRS(pm_, pn_, br_, a_, b_, nt_) do { \
        if (MODE == 4) { const int acol = (br_) == 0 ? 1280 : ((br_) == 1 ? 3584 : 6400), bk = (br_) == 0 ? 0 : ((br_) == 1 ? 768 : 1280); nt_ = (br_) == 1 ? 8 : 12; \
            a_ = Abase + (size_t)(pm_) * 256 * lda + (size_t)acol * 2; b_ = Bbase + (size_t)(pn_) * 256 * ldb + (size_t)bk * 2; } \
        else { nt_ = 32; a_ = Abase + (size_t)(pm_) * 256 * lda; b_ = Bbase + (size_t)(pn_) * 256 * ldb; } } while (0)
    int pm, pn, br, npm, npn, nbr; int ui = 0;
    if (!gs_next<PER>(S, 0, pm, pn, br)) return;
    f32x4 acc[2][2][4][2];
#pragma unroll
    for (int a = 0; a < 2; ++a)
#pragma unroll
        for (int b = 0; b < 2; ++b)
#pragma unroll
            for (int m = 0; m < 4; ++m)
#pragma unroll
                for (int n = 0; n < 2; ++n) acc[a][b][m][n] = (f32x4){0.f, 0.f, 0.f, 0.f};
    bf16x8 At[4][2], B0[2][2], B1[2][2];
    const char* cA; const char* cB; int nt;
    UNIT_PTRS(pm, pn, br, cA, cB, nt);
    PG8_STAGE(PG8_SB(0, 0), cB, voffB); PG8_STAGE(PG8_SB(0, 1), cB + hstepB, voffB); PG8_STAGE(PG8_SA(0, 0), cA, voffA); PG8_STAGE(PG8_SA(0, 1), cA + hstepA, voffA);
    if (wr == 1) PG8_BAR;
    PG8_WAIT_V(2); PG8_BAR;
    PG8_STAGE(PG8_SB(1, 0), cB + kstep, voffB); PG8_STAGE(PG8_SA(1, 0), cA + kstep, voffA); PG8_STAGE(PG8_SB(1, 1), cB + hstepB + kstep, voffB);
    PG8_WAIT_V(6); PG8_BAR;
    for (;;) {
        const bool has_next = gs_next<PER>(S, ui + 1, npm, npn, nbr);
        const char* nA = cA; const char* nB = cB; int nnt = nt;
        if (has_next) { UNIT_PTRS(npm, npn, nbr, nA, nB, nnt); }
        for (int t = 0; t < nt; t += 2) {
            const bool last = (t == nt - 2);
            const char* a1 = cA + (size_t)(t + 1) * kstep;
            const char* a2 = last ? nA : cA + (size_t)(t + 2) * kstep; const char* b2 = last ? nB : cB + (size_t)(t + 2) * kstep;
            const char* a3 = a2 + kstep; const char* b3 = b2 + kstep;
            PG8_LDB(B0, 0, 0); PG8_LDB(B1, 0, 1); PG8_SCHED; PG8_LDA(At, 0, 0); PG8_STAGE(PG8_SA(1, 1), a1 + hstepA, voffA);
            PG8_WAIT_V(8); PG8_WAIT_L(0); PG8_BAR; PG8_MMA(0, 0, At, B0); PG8_MMA(0, 1, At, B1); PG8_BAR; PG8_SCHED;
            PG8_LDA(At, 0, 1); PG8_STAGE(PG8_SB(0, 0), b2, voffB); PG8_STAGE(PG8_SB(0, 1), b2 + hstepB, voffB); PG8_STAGE(PG8_SA(0, 0), a2, voffA);
            PG8_WAIT_V(8); PG8_WAIT_L(0); PG8_BAR; PG8_MMA(1, 0, At, B0); PG8_MMA(1, 1, At, B1); PG8_BAR; PG8_SCHED;
            PG8_LDB(B0, 1, 0); PG8_LDB(B1, 1, 1); PG8_SCHED; PG8_LDA(At, 1, 0); PG8_STAGE(PG8_SA(0, 1), a2 + hstepA, voffA);
            PG8_WAIT_V(8); PG8_WAIT_L(0); PG8_BAR; PG8_MMA(0, 0, At, B0); PG8_MMA(0, 1, At, B1); PG8_BAR; PG8_SCHED;
            PG8_LDA(At, 1, 1); PG8_STAGE(PG8_SB(1, 0), b3, voffB); PG8_STAGE(PG8_SB(1, 1), b3 + hstepB, voffB); PG8_STAGE(PG8_SA(1, 0), a3, voffA);
            PG8_WAIT_V(8); PG8_WAIT_L(0); PG8_BAR; PG8_MMA(1, 0, At, B0); PG8_MMA(1, 1, At, B1); PG8_BAR; PG8_SCHED;
        }
        if (wr == 0) PG8_BAR;
        {
            const int row0 = pm * BM + wr * 64 + fr;
            if (MODE == 2) {
                const int colt = pn * BM + wc * 32 + 8 * fq;
                const bool isu = pn < 28;
                bf16_t* dst = isu ? (bf16_t*)(P.ws + OFF_U7) + colt : (bf16_t*)(P.ws + OFF_MG) + (colt - U7W);
                const int ldd = isu ? U7W : MGW;
                float* kvo = nullptr; int kvw = 0, kvc = 0;
                if (ck.tok0 + pm * BM < NCTXTOK) {
                    if (pn == 3) { kvo = P.out + OUT_AK; kvw = 256; kvc = colt - 768; }
                    else if (pn == 4) { kvo = P.out + OUT_AV; kvw = 256; kvc = colt - 1024; }
                    else if (pn >= 19 && pn < 22) { kvo = P.out + OUT_CK; kvw = 768; kvc = colt - 4864; }
                    else if (pn >= 22 && pn < 25) { kvo = P.out + OUT_CV; kvw = 768; kvc = colt - 5632; }
                }
#pragma unroll
                for (int ai = 0; ai < 2; ++ai)
#pragma unroll
                    for (int m = 0; m < 4; ++m) {
                        const int r = row0 + ai * HALF + m * 16;
#pragma unroll
                        for (int bj = 0; bj < 2; ++bj) {
                            const f32x4 v0 = acc[ai][bj][m][0], v1 = acc[ai][bj][m][1];
                            u32x4 w; w.x = cvt_pk_bf16(v0[0], v0[1]); w.y = cvt_pk_bf16(v0[2], v0[3]); w.z = cvt_pk_bf16(v1[0], v1[1]); w.w = cvt_pk_bf16(v1[2], v1[3]);
                            *(u32x4*)(dst + (size_t)r * ldd + bj * HALF) = w;
                            if (kvo) { const int g = ck.tok0 + r; const int bb = g >> 8, s = g & 255;
                                float* o = kvo + ((size_t)(bb * 2 + layer) * 256 + s) * kvw + kvc + bj * HALF;
                                *(f32x4*)o = v0; *(f32x4*)(o + 4) = v1; }
                        }
                    }
            } else if (MODE == 4) {
                const int colt = pn * BM + wc * 32 + 8 * fq;
                const bf16_t* mg = (const bf16_t*)(P.ws + OFF_MG);
                bf16_t* mo = (bf16_t*)(P.ws + OFF_H);
#pragma unroll
                for (int ai = 0; ai < 2; ++ai)
#pragma unroll
                    for (int m = 0; m < 4; ++m) {
                        const int r = row0 + ai * HALF + m * 16;
#pragma unroll
                        for (int bj = 0; bj < 2; ++bj) {
                            const int c0 = colt + bj * HALF;
                            const bf16_t* mr = mg + (size_t)r * MGW + c0;
                            float f[8];
                            if (br == 0) { const u32x4 ga = *(const u32x4*)mr, gb = *(const u32x4*)(mr + 2048);
#pragma unroll
                                for (int e = 0; e < 4; ++e) { f[2 * e] = (1.f + __expf(-bf_lo(gb[e]))) / (1.f + __expf(-bf_lo(ga[e]))); f[2 * e + 1] = (1.f + __expf(-bf_hi(gb[e]))) / (1.f + __expf(-bf_hi(ga[e]))); } }
                            else if (br == 1) { const u32x4 ga = *(const u32x4*)(mr + 2048), gb = *(const u32x4*)(mr + 4096);
#pragma unroll
                                for (int e = 0; e < 4; ++e) { f[2 * e] = (1.f + __expf(-bf_lo(gb[e]))) / (1.f + __expf(-bf_lo(ga[e]))); f[2 * e + 1] = (1.f + __expf(-bf_hi(gb[e]))) / (1.f + __expf(-bf_hi(ga[e]))); } }
                            else { const u32x4 ga = *(const u32x4*)(mr + 4096);
#pragma unroll
                                for (int e = 0; e < 4; ++e) { f[2 * e] = 1.f / (1.f + __expf(-bf_lo(ga[e]))); f[2 * e + 1] = 1.f / (1.f + __expf(-bf_hi(ga[e]))); } }
                            f32x4 v0 = acc[ai][bj][m][0], v1 = acc[ai][bj][m][1];
                            v0[0] *= f[0]; v0[1] *= f[1]; v0[2] *= f[2]; v0[3] *= f[3]; v1[0] *= f[4]; v1[1] *= f[5]; v1[2] *= f[6]; v1[3] *= f[7];
                            if (br == 2) { u32x4 w; w.x = cvt_pk_bf16(v0[0], v0[1]); w.y = cvt_pk_bf16(v0[2], v0[3]); w.z = cvt_pk_bf16(v1[0], v1[1]); w.w = cvt_pk_bf16(v1[2], v1[3]);
                                *(u32x4*)(mo + (size_t)r * D + c0) = w; v0 = (f32x4){0.f, 0.f, 0.f, 0.f}; v1 = v0; }
                            acc[ai][bj][m][0] = v0; acc[ai][bj][m][1] = v1;
                        }
                    }
            } else {
                const int colt = pn * BM + wc * 32 + 4 * fq;
#pragma unroll
                for (int ai = 0; ai < 2; ++ai)
#pragma unroll
                    for (int m = 0; m < 4; ++m) {
                        const int r = row0 + ai * HALF + m * 16; const int g = ck.tok0 + r;
                        const float* xo = (layer == 0) ? (g < NCTXTOK ? P.in[I_XP] + (size_t)g * D : P.in[I_XS] + (size_t)(g - NCTXTOK) * D) : P.out + (size_t)g * D;
                        float* yo = P.out + (size_t)g * D;
                        const float* gt = (const float*)(P.ws + OFF_MOD) + ((size_t)layer * 9 + cond_of(g)) * 6144 + 4096;
#pragma unroll
                        for (int bj = 0; bj < 2; ++bj)
#pragma unroll
                            for (int n = 0; n < 2; ++n) { const int c = colt + bj * HALF + n * 16;
                                const f32x4 xv = *(const f32x4*)(xo + c), gv = *(const f32x4*)(gt + c);
                                *(f32x4*)(yo + c) = xv + gv * acc[ai][bj][m][n]; }
                    }
            }
        }
        if (!has_next) break;
        if (MODE != 4) {
#pragma unroll
            for (int a = 0; a < 2; ++a)
#pragma unroll
                for (int b = 0; b < 2; ++b)
#pragma unroll
                    for (int m = 0; m < 4; ++m)
#pragma unroll
                        for (int n = 0; n < 2; ++n) acc[a][b][m][n] = (f32x4){0.f, 0.f, 0.f, 0.f};
        }
        pm = npm; pn = npn; br = nbr; cA = nA; cB = nB; nt = nnt; ++ui;
        if (wr == 1) PG8_BAR;
    }
    PG8_WAIT_V(0);
    PG8_BAR;
#undef PG8_SA
#undef PG8_SB
#undef PG8_STAGE
#undef PG8_LDA
#undef PG8_LDB
#undef PG8_MMA
#undef PG8_WAIT_V
#undef PG8_WAIT_L
#undef PG8_BAR
#undef PG8_SCHED
#undef UNIT_PTRS
}

#define PHYS(i) ((i) + ((i) >> 4))
constexpr int FFT_DATA_BYTES = (8192 + 512) * 8;
__device__ __forceinline__ float2 cmul(float2 a, float2 b) { return make_float2(a.x * b.x - a.y * b.y, a.x * b.y + a.y * b.x); }
__device__ __forceinline__ float2 cmulc(float2 a, float2 b) { return make_float2(a.x * b.x + a.y * b.y, a.y * b.x - a.x * b.y); }
__device__ __forceinline__ float2 root16(int n) {
    const float c1 = 0.92387953251128674f, s1 = 0.38268343236508977f, h = 0.70710678118654752f;
    switch (n) { case 0: return make_float2(1.f, 0.f); case 1: return make_float2(c1, -s1); case 2: return make_float2(h, -h); case 3: return make_float2(s1, -c1);
                 case 4: return make_float2(0.f, -1.f); case 5: return make_float2(-s1, -c1); case 6: return make_float2(-h, -h); default: return make_float2(-c1, -s1); }
}
template <int R, bool INV, bool TW>
__device__ __forceinline__ void fft_regs(float2 (&x)[1 << R], const float2 (&w)[R]) {
    constexpr int NP = 1 << R;
    if (!INV) {
#pragma unroll
        for (int s = 0; s < R; ++s) { const int h = 1 << (R - 1 - s);
#pragma unroll
            for (int k = 0; k < NP; ++k) if (!(k & h)) { const int q = k & (h - 1);
                const float2 a = x[k], b = x[k + h]; x[k] = make_float2(a.x + b.x, a.y + b.y);
                float2 t = make_float2(a.x - b.x, a.y - b.y); if (TW) t = cmul(t, w[s]); x[k + h] = cmul(t, root16(q * (8 / h))); } }
    } else {
#pragma unroll
        for (int s = R - 1; s >= 0; --s) { const int h = 1 << (R - 1 - s);
#pragma unroll
            for (int k = 0; k < NP; ++k) if (!(k & h)) { const int q = k & (h - 1);
                const float2 a = x[k]; float2 b = cmulc(x[k + h], root16(q * (8 / h))); if (TW) b = cmulc(b, w[s]);
                x[k] = make_float2(a.x + b.x, a.y + b.y); x[k + h] = make_float2(a.x - b.x, a.y - b.y); } }
    }
}
template <int S, int R, bool INV>
__device__ __forceinline__ void fft_pass(float2* d, const float2* tw, int tid) {
    constexpr int NP = 1 << R, GPT = (8192 >> R) / NTHREADS;
#pragma unroll
    for (int g = 0; g < GPT; ++g) {
        const int gid = tid + NTHREADS * g, r = gid & (S - 1), base = (gid / S) * (S << R) + r;
        float2 x[NP], w[R];
#pragma unroll
        for (int k = 0; k < NP; ++k) x[k] = d[PHYS(base + k * S)];
        w[0] = tw[r * (8192 / (S << R))];
#pragma unroll
        for (int s = 1; s < R; ++s) w[s] = cmul(w[s - 1], w[s - 1]);
        fft_regs<R, INV, true>(x, w);
#pragma unroll
        for (int k = 0; k < NP; ++k) d[PHYS(base + k * S)] = x[k];
    }
    __syncthreads();
}
__device__ __forceinline__ void fft_fwd_hi(float2* d, const float2* tw, bool lng, int tid) {
    if (lng) fft_pass<512, 4, false>(d, tw, tid);
    fft_pass<128, 2, false>(d, tw, tid);
    fft_pass<16, 3, false>(d, tw, tid);
}
__device__ __forceinline__ void fft_inv_hi(float2* d, const float2* tw, bool lng, int tid) {
    fft_pass<16, 3, true>(d, tw, tid);
    fft_pass<128, 2, true>(d, tw, tid);
    if (lng) fft_pass<512, 4, true>(d, tw, tid);
}
template <bool CONV>
__device__ __forceinline__ void fft_mid(float2* d, const float2* spec_in, float2* spec_out, float scale, int spmask, int tid) {
    float2 x[16]; const float2 w[4] = {make_float2(1.f, 0.f), make_float2(1.f, 0.f), make_float2(1.f, 0.f), make_float2(1.f, 0.f)};
    float2* p = d + 17 * tid;
#pragma unroll
    for (int k = 0; k < 16; ++k) x[k] = p[k];
    fft_regs<4, false, false>(x, w);
    if (CONV) {
        const f32x4* sp = (const f32x4*)(spec_in + ((16 * tid) & spmask));
#pragma unroll
        for (int k2 = 0; k2 < 8; ++k2) { const f32x4 sv = sp[k2]; x[2 * k2] = cmul(x[2 * k2], make_float2(sv[0], sv[1])); x[2 * k2 + 1] = cmul(x[2 * k2 + 1], make_float2(sv[2], sv[3])); }
        fft_regs<4, true, false>(x, w);
#pragma unroll
        for (int k = 0; k < 16; ++k) p[k] = x[k];
    } else {
        f32x4* so = (f32x4*)(spec_out + 16 * tid);
#pragma unroll
        for (int k2 = 0; k2 < 8; ++k2) so[k2] = (f32x4){x[2 * k2].x * scale, x[2 * k2].y * scale, x[2 * k2 + 1].x * scale, x[2 * k2 + 1].y * scale};
    }
    __syncthreads();
}
__device__ __forceinline__ void fft_init_tw(float2* tw, int tid) {
    for (int k = tid; k < 4096; k += NTHREADS) { float s, c; sincospif((float)k * (1.f / 4096.f), &s, &c); tw[k] = make_float2(c, -s); }
    __syncthreads();
}

__device__ __forceinline__ void phase0(const Params& P, unsigned char* smem) {
    int tid_ = threadIdx.x; asm volatile("" : "+v"(tid_));
    const int tid = tid_, lane = tid & 63, wave = tid >> 6;
    for (int it = blockIdx.x; it < 192 + 1 + 136; it += gridDim.x) {
        __syncthreads();
        if (it < 192) {
            const int l = it / 96, col0 = (it % 96) * 64;
            float* s = (float*)smem; float* red = (float*)(smem + 9 * 2048 * 4);
            for (int i = tid; i < 9 * 2048; i += NTHREADS) { const int v = i >> 11, k = i & 2047; const float x = (v == 0) ? P.in[I_CCTX][k] : P.in[I_C][(v - 1) * 2048 + k]; s[i] = x / (1.f + expf(-x)); }
            __syncthreads();
            const int kg = tid >> 4, cj = tid & 15;
            float acc[9][4];
#pragma unroll
            for (int v = 0; v < 9; ++v) { acc[v][0] = 0.f; acc[v][1] = 0.f; acc[v][2] = 0.f; acc[v][3] = 0.f; }
            const float* wp = P.in[I_WADA] + (size_t)l * 2048 * 6144 + col0 + 4 * cj;
#pragma unroll 4
            for (int k = kg; k < 2048; k += 32) { const f32x4 w = *(const f32x4*)(wp + (size_t)k * 6144);
#pragma unroll
                for (int v = 0; v < 9; ++v) { const float sv = s[v * 2048 + k]; acc[v][0] += sv * w[0]; acc[v][1] += sv * w[1]; acc[v][2] += sv * w[2]; acc[v][3] += sv * w[3]; } }
#pragma unroll
            for (int v = 0; v < 9; ++v)
#pragma unroll
                for (int e = 0; e < 4; ++e) { float a = acc[v][e]; a += __shfl_xor(a, 16); a += __shfl_xor(a, 32); acc[v][e] = a; }
            if (lane < 16) {
#pragma unroll
                for (int v = 0; v < 9; ++v)
#pragma unroll
                    for (int e = 0; e < 4; ++e) red[(wave * 16 + cj) * 36 + v * 4 + e] = acc[v][e];
            }
            __syncthreads();
            for (int i = tid; i < 9 * 64; i += NTHREADS) { const int v = i >> 6, cc = i & 63; float a = P.in[I_BADA][l * 6144 + col0 + cc];
                for (int w = 0; w < 8; ++w) a += red[(w * 16 + (cc >> 2)) * 36 + v * 4 + (cc & 3)];
                ((float*)(P.ws + OFF_MOD))[((size_t)l * 9 + v) * 6144 + col0 + cc] = a; }
        } else if (it == 192) {
            float2* tab = (float2*)(P.ws + OFF_ROPE);
            for (int i = tid; i < 1024; i += NTHREADS) { const int pos = i >> 4, f = i & 15; const float inv = powf(10000.f, -(float)f / 16.f); const float ang = (float)pos * inv; tab[i] = make_float2(cosf(ang), sinf(ang)); }
        } else {
            const int j = it - 193, l = j / 68, tb = j % 68;
            const bool lng = tb < 64; const int t0 = lng ? tb * 64 : (tb - 64) * 64; const float invL = lng ? (1.f / 4096.f) : (1.f / 256.f);
            const int rowoff = l * 4352 + (lng ? 0 : 4096) + t0;
            float* feats = (float*)smem; float* z1 = feats + 64 * 33;
            for (int i = tid; i < 64 * 33; i += NTHREADS) { const int tl = i / 33, f = i % 33; const float t = (float)(t0 + tl) * invL;
                float v; if (f == 0) v = t; else if (f <= 16) v = sinpif(2.f * (float)f * t); else v = cospif(2.f * (float)(f - 16) * t); feats[i] = v; }
            __syncthreads();
            const int tl = tid >> 3, part = tid & 7;
            const float* w1 = P.in[I_HW1] + (size_t)l * 33 * 64; const float* b1 = P.in[I_HB1] + l * 64; const float* fr0 = P.in[I_HFREQ] + l * 128;
            for (int jj = 0; jj < 8; ++jj) { const int jo = part * 8 + jj; float a = b1[jo];
                for (int f = 0; f < 33; ++f) a += feats[tl * 33 + f] * w1[f * 64 + jo];
                z1[tl * 65 + jo] = sinf(fr0[jo] * a); }
            __syncthreads();
            const float* w2 = P.in[I_HW2] + (size_t)l * 64 * 64; const float* b2 = P.in[I_HB2] + l * 64; const float* fr1 = fr0 + 64;
            float* z2 = (float*)(P.ws + OFF_Z2);
            for (int jj = 0; jj < 8; ++jj) { const int jo = part * 8 + jj; float a = b2[jo];
                for (int f = 0; f < 64; ++f) a += z1[tl * 65 + f] * w2[f * 64 + jo];
                z2[(size_t)(rowoff + tl) * 64 + jo] = sinf(fr1[jo] * a); }
        }
    }
}

__device__ __forceinline__ void transpose_item(const float* W, int N, bf16_t* WT, int koff, int item, float* s, int tid) {
    const int nb = N / 128, kb = item / nb, nbk = item % nb, k0 = kb * 64, n0 = nbk * 128;
#pragma unroll
    for (int i = 0; i < 4; ++i) { const int kk = i * 16 + (tid >> 5), c4 = tid & 31; const f32x4 w = *(const f32x4*)(W + (size_t)(k0 + kk) * N + n0 + 4 * c4);
        float* d = s + kk * 129 + 4 * c4; d[0] = w[0]; d[1] = w[1]; d[2] = w[2]; d[3] = w[3]; }
    __syncthreads();
#pragma unroll
    for (int j = 0; j < 2; ++j) { const int n = (tid >> 3) + 64 * j, c8 = tid & 7; const float* q = s + (8 * c8) * 129 + n;
        u32x4 o; o.x = cvt_pk_bf16(q[0], q[129]); o.y = cvt_pk_bf16(q[2 * 129], q[3 * 129]); o.z = cvt_pk_bf16(q[4 * 129], q[5 * 129]); o.w = cvt_pk_bf16(q[6 * 129], q[7 * 129]);
        *(u32x4*)(WT + (size_t)(n0 + n) * 2048 + koff + k0 + 8 * c8) = o; }
    __syncthreads();
}

__device__ __forceinline__ void phase1(const Params& P, unsigned char* smem, const int layer, const int cidx, const Chunk ck) {
    int tid_ = threadIdx.x; asm volatile("" : "+v"(tid_));
    const int tid = tid_, lane = tid & 63, wave = tid >> 6;
    if (cidx == 0) {
        float2* data = (float2*)smem; float2* tw = (float2*)(smem + FFT_DATA_BYTES); float* w3s = (float*)(smem + FFT_DATA_BYTES + 32768);
        fft_init_tw(tw, tid);
        const float* z2 = (const float*)(P.ws + OFF_Z2) + (size_t)layer * 4352 * 64;
        const float* w3 = P.in[I_HW3] + (size_t)layer * 64 * 2048;
        const float* dec = P.in[I_HDEC] + layer * 2048;
        const float* skp = P.in[I_HSKIP] + layer * 1024;
        for (int it = blockIdx.x; it < 1024; it += gridDim.x) {
            const int o = it >> 9, c = it & 511;
            __syncthreads();
            if (tid < 128) { const int d = tid >> 6, j = tid & 63; w3s[tid] = w3[j * 2048 + o * 1024 + d * 512 + c]; }
            __syncthreads();
            const float df = fabsf(dec[o * 1024 + c]), db = fabsf(dec[o * 1024 + 512 + c]), sk = skp[o * 512 + c];
#pragma unroll 1
            for (int i = 0; i < 8; ++i) { const int t = tid + 512 * i; const f32x4* zr = (const f32x4*)(z2 + (size_t)t * 64);
                float af = 0.f, ab = 0.f;
#pragma unroll
                for (int j4 = 0; j4 < 16; ++j4) { const f32x4 z = zr[j4];
#pragma unroll
                    for (int e = 0; e < 4; ++e) { af += z[e] * w3s[j4 * 4 + e]; ab += z[e] * w3s[64 + j4 * 4 + e]; } }
                const float tt = (float)t * (1.f / 4096.f);
                af *= expf(-df * tt); ab *= expf(-db * tt);
                if (t == 0) { data[0] = make_float2(af + sk, 0.f); data[PHYS(4096)] = make_float2(0.f, 0.f); }
                else { data[PHYS(t)] = make_float2(af, 0.f); data[PHYS(8192 - t)] = make_float2(ab, 0.f); } }
            __syncthreads();
            fft_fwd_hi(data, tw, true, tid);
            fft_mid<false>(data, nullptr, (float2*)(P.ws + OFF_SPECL) + (size_t)(o * 512 + c) * 8192, 1.f / 8192.f, 0, tid);
        }
        for (int it = blockIdx.x; it < 64; it += gridDim.x) {
            const int o = it >> 5, c0 = (it & 31) * 16;
            __syncthreads();
            const int q = tid >> 5, ts = tid & 31, c = c0 + q;
            const float df = fabsf(dec[o * 1024 + c]), db = fabsf(dec[o * 1024 + 512 + c]), sk = skp[o * 512 + c];
#pragma unroll 1
            for (int i = 0; i < 8; ++i) { const int t = ts + 32 * i; const float* zr = z2 + (size_t)(4096 + t) * 64;
                float af = 0.f, ab = 0.f;
#pragma unroll 4
                for (int j = 0; j < 64; ++j) { const float z = zr[j]; af += z * w3[j * 2048 + o * 1024 + c]; ab += z * w3[j * 2048 + o * 1024 + 512 + c]; }
                const float tt = (float)t * (1.f / 256.f);
                af *= expf(-df * tt); ab *= expf(-db * tt);
                if (t == 0) { data[PHYS(q * 512)] = make_float2(af + sk, 0.f); data[PHYS(q * 512 + 256)] = make_float2(0.f, 0.f); }
                else { data[PHYS(q * 512 + t)] = make_float2(af, 0.f); data[PHYS(q * 512 + 512 - t)] = make_float2(ab, 0.f); } }
            __syncthreads();
            fft_fwd_hi(data, tw, false, tid);
            fft_mid<false>(data, nullptr, (float2*)(P.ws + OFF_SPECS) + (size_t)(o * 512 + c0) * 512, 1.f / 512.f, 0, tid);
        }
        __syncthreads();
        float* s = (float*)smem;
        for (int it = blockIdx.x; it < 4352; it += gridDim.x) {
            int r = it;
            if (r < 3328) { transpose_item(P.in[I_WIN] + (size_t)layer * 2048 * INW, INW, (bf16_t*)(P.ws + OFF_WTIN), 0, r, s, tid); continue; } r -= 3328;
            if (r < 512) { transpose_item(P.in[I_WOUT] + (size_t)layer * 2048 * 2048, 2048, (bf16_t*)(P.ws + OFF_WTOUT), 0, r, s, tid); continue; } r -= 512;
            if (r < 192) { transpose_item(P.in[I_WUA] + (size_t)layer * 768 * 2048, 2048, (bf16_t*)(P.ws + OFF_WTUP), 0, r, s, tid); continue; } r -= 192;
            if (r < 128) { transpose_item(P.in[I_WUB] + (size_t)layer * 512 * 2048, 2048, (bf16_t*)(P.ws + OFF_WTUP), 768, r, s, tid); continue; } r -= 128;
            transpose_item(P.in[I_WUC] + (size_t)layer * 768 * 2048, 2048, (bf16_t*)(P.ws + OFF_WTUP), 1280, r, s, tid);
        }
    }
    const float* nw = P.in[I_NW] + layer * D;
    for (int it = blockIdx.x; it < ck.ntok / 64; it += gridDim.x) {
#pragma unroll 1
        for (int i = 0; i < 8; ++i) {
            const int r = it * 64 + wave * 8 + i, g = ck.tok0 + r;
            const float* x = (layer == 0) ? (g < NCTXTOK ? P.in[I_XP] + (size_t)g * D : P.in[I_XS] + (size_t)(g - NCTXTOK) * D) : P.out + (size_t)g * D;
            const float* md = (const float*)(P.ws + OFF_MOD) + ((size_t)layer * 9 + cond_of(g)) * 6144;
            f32x4 v[8]; float ss = 0.f;
#pragma unroll
            for (int j = 0; j < 8; ++j) { v[j] = *(const f32x4*)(x + lane * 4 + 256 * j); ss += v[j][0] * v[j][0] + v[j][1] * v[j][1] + v[j][2] * v[j][2] + v[j][3] * v[j][3]; }
            const float rstd = rsqrtf(wave_sum(ss) * (1.f / D) + 1e-6f);
            bf16_t* h = (bf16_t*)(P.ws + OFF_H) + (size_t)r * D;
#pragma unroll
            for (int j = 0; j < 8; ++j) { const int k = lane * 4 + 256 * j; const f32x4 w = *(const f32x4*)(nw + k), sh = *(const f32x4*)(md + k), sc = *(const f32x4*)(md + 2048 + k);
                f32x4 y;
#pragma unroll
                for (int e = 0; e < 4; ++e) y[e] = v[j][e] * rstd * w[e] * (1.f + sc[e]) + sh[e];
                u32x2 o; o.x = cvt_pk_bf16(y[0], y[1]); o.y = cvt_pk_bf16(y[2], y[3]); *(u32x2*)(h + k) = o; }
        }
    }
}

__device__ __forceinline__ void hy_transpose_item(const Params& P, float* s, const int layer, const Chunk ck, int item, int tid) {
    const int tb = item >> 3, cb = item & 7, t0 = tb * 64;
    const int ctxrows = ck.nctxb * 256;
    const int Ls = (t0 < ctxrows) ? 256 : 4096; const int tin = (t0 < ctxrows) ? (t0 & 255) : ((t0 - ck.lat_row0) & 4095);
    const bool first = (tin == 0), lastb = (tin + 64 == Ls);
    const bf16_t* U = (const bf16_t*)(P.ws + OFF_U7);
    for (int idx = tid; idx < 66 * 32; idx += NTHREADS) { const int rr = idx >> 5, ch = idx & 31;
        const bool valid = !((rr == 0 && first) || (rr == 65 && lastb));
        u32x4 w = (u32x4){0u, 0u, 0u, 0u};
        if (valid) w = *(const u32x4*)(U + (size_t)(t0 - 1 + rr) * U7W + 2048 + cb * 256 + ch * 8);
        float* d = s + rr * 257 + ch * 8; d[0] = bf_lo(w.x); d[1] = bf_hi(w.x); d[2] = bf_lo(w.y); d[3] = bf_hi(w.y); d[4] = bf_lo(w.z); d[5] = bf_hi(w.z); d[6] = bf_lo(w.w); d[7] = bf_hi(w.w); }
    __syncthreads();
    const int tch = tid & 7;
#pragma unroll
    for (int j = 0; j < 4; ++j) {
        const int col = (tid >> 3) + 64 * j, cc = cb * 256 + col;
        float o[8];
        if (cb < 6) { const float* cw = P.in[I_HCW] + (size_t)layer * 3 * 1536; const float w0 = cw[cc], w1 = cw[1536 + cc], w2 = cw[3072 + cc], bb = P.in[I_HCB][layer * 1536 + cc];
#pragma unroll
            for (int i = 0; i < 8; ++i) { const int t = tch * 8 + i; o[i] = bb + w0 * s[t * 257 + col] + w1 * s[(t + 1) * 257 + col] + w2 * s[(t + 2) * 257 + col]; } }
        else {
#pragma unroll
            for (int i = 0; i < 8; ++i) { const int t = tch * 8 + i; o[i] = s[(t + 1) * 257 + col]; } }
        u32x4 w; w.x = cvt_pk_bf16(o[0], o[1]); w.y = cvt_pk_bf16(o[2], o[3]); w.z = cvt_pk_bf16(o[4], o[5]); w.w = cvt_pk_bf16(o[6], o[7]);
        *(u32x4*)((bf16_t*)(P.ws + OFF_H) + (size_t)cc * ck.ntok + t0 + tch * 8) = w;
    }
    __syncthreads();
}

typedef short s16x4 __attribute__((ext_vector_type(4)));
struct AttnSt { float mrun, lsum; f32x4 o[4]; };
template <int MASK>
__device__ __forceinline__ void attn_tile(AttnSt& st_, const bf16_t* Ks, const bf16_t* Vs, const bf16x8 (&qf)[2], const float* rpbs, int qrow, int ttok0, int fr, int fq) {
    const float C1 = 0.125f * 1.4426950408889634f, LOG2E = 1.4426950408889634f;
    f32x4 sc[4];
#pragma unroll
    for (int st = 0; st < 4; ++st) { sc[st] = (f32x4){0.f, 0.f, 0.f, 0.f};
#pragma unroll
        for (int ks = 0; ks < 2; ++ks) { const bf16x8 a = *(const bf16x8*)(Ks + (st * 16 + fr) * 72 + ks * 32 + fq * 8); sc[st] = __builtin_amdgcn_mfma_f32_16x16x32_bf16(a, qf[ks], sc[st], 0, 0, 0); } }
    float mx = st_.mrun;
    if (MASK == 0) {
#pragma unroll
        for (int st = 0; st < 4; ++st)
#pragma unroll
            for (int i = 0; i < 4; ++i) { const float sv = sc[st][i] * C1; sc[st][i] = sv; mx = __builtin_fmaxf(mx, sv); }
    } else if (MASK == 1) {
        const int dl = qrow - ttok0 - fq * 4 + 128;
#pragma unroll
        for (int st = 0; st < 4; ++st)
#pragma unroll
            for (int i = 0; i < 4; ++i) { const bool ok = (unsigned)(dl - (st * 16 + i)) <= 256u; const float sv = ok ? sc[st][i] * C1 : -1e30f; sc[st][i] = sv; mx = __builtin_fmaxf(mx, sv); }
    } else {
        const int kr = ttok0 >> 6, r = qrow >> 6, w = qrow & 63; int rs = r - 4; rs = rs < 0 ? 0 : (rs > 56 ? 56 : rs); int cs = w - 8; cs = cs < 0 ? 0 : (cs > 48 ? 48 : cs);
        const bool rowok = (kr >= rs) && (kr < rs + 8);
        const int kk0 = fq * 4, brow = (kr - r + 7) * 31 - w + 15 + kk0, cl = kk0 - cs;
        float bias[16];
#pragma unroll
        for (int st = 0; st < 4; ++st)
#pragma unroll
            for (int i = 0; i < 4; ++i) { const bool ok = rowok && ((unsigned)(cl + st * 16 + i) < 16u); bias[st * 4 + i] = rpbs[ok ? brow + st * 16 + i : 0]; }
#pragma unroll
        for (int st = 0; st < 4; ++st)
#pragma unroll
            for (int i = 0; i < 4; ++i) { const bool ok = rowok && ((unsigned)(cl + st * 16 + i) < 16u); const float sv = ok ? sc[st][i] * C1 + bias[st * 4 + i] * LOG2E : -1e30f; sc[st][i] = sv; mx = __builtin_fmaxf(mx, sv); }
    }
    mx = __builtin_fmaxf(mx, __shfl_xor(mx, 16)); mx = __builtin_fmaxf(mx, __shfl_xor(mx, 32));
    const float alpha = __builtin_amdgcn_exp2f(st_.mrun - mx); st_.mrun = mx; float ls = st_.lsum * alpha;
#pragma unroll
    for (int dt = 0; dt < 4; ++dt) st_.o[dt] *= alpha;
#pragma unroll
    for (int st = 0; st < 4; ++st)
#pragma unroll
        for (int i = 0; i < 4; ++i) { const float p = __builtin_amdgcn_exp2f(sc[st][i] - mx); ls += p; sc[st][i] = p; }
    st_.lsum = ls;
#pragma unroll
    for (int k2 = 0; k2 < 2; ++k2) {
        u32x4 pw; pw.x = cvt_pk_bf16(sc[2 * k2][0], sc[2 * k2][1]); pw.y = cvt_pk_bf16(sc[2 * k2][2], sc[2 * k2][3]); pw.z = cvt_pk_bf16(sc[2 * k2 + 1][0], sc[2 * k2 + 1][1]); pw.w = cvt_pk_bf16(sc[2 * k2 + 1][2], sc[2 * k2 + 1][3]);
        const bf16x8 pb = __builtin_bit_cast(bf16x8, pw);
#pragma unroll
        for (int dt = 0; dt < 4; ++dt) { const bf16_t* vp = Vs + (32 * k2 + fq * 4 + (fr >> 2)) * 72 + dt * 16 + 4 * (fr & 3);
            const s16x4 v0 = __builtin_amdgcn_ds_read_tr16_b64_v4i16((LAS s16x4*)vp), v1 = __builtin_amdgcn_ds_read_tr16_b64_v4i16((LAS s16x4*)(vp + 16 * 72));
            bf16x8 aw; aw[0] = v0[0]; aw[1] = v0[1]; aw[2] = v0[2]; aw[3] = v0[3]; aw[4] = v1[0]; aw[5] = v1[1]; aw[6] = v1[2]; aw[7] = v1[3];
            st_.o[dt] = __builtin_amdgcn_mfma_f32_16x16x32_bf16(aw, pb, st_.o[dt], 0, 0, 0); }
    }
}
template <int NG>
__device__ __forceinline__ void attn_item(const Params& P, unsigned char* smem, const int layer, const Chunk ck, int kind, int b, int hh_, int qb) {
    int tid_ = threadIdx.x; asm volatile("" : "+v"(tid_));
    const int tid = tid_, lane = tid & 63, wave = tid >> 6, fr = lane & 15, fq = lane >> 4;
    bf16_t* KV = (bf16_t*)smem;
    float* rpbs = (float*)(smem + 4 * 64 * 72 * 2);
    bf16_t* U = (bf16_t*)(P.ws + OFF_U7);
    const bool lat = kind < 2, isA = (NG == 3);
    const int seq_row0 = lat ? ck.lat_row0 + (b - ck.latb0) * 4096 : b * 256;
    const int QR = isA ? 128 : 256;
    const int q0 = qb * QR;
    const int kh = hh_;
    const int kcol = isA ? 768 + kh * 64 : 4864 + kh * 64, vcol = isA ? 1024 + kh * 64 : 5632 + kh * 64;
    int lt0, nlt;
    if (kind == 0) { const int a = q0 - 128 < 0 ? 0 : q0 - 128, e = q0 + 256 > 4096 ? 4096 : q0 + 256; lt0 = a; nlt = (e - a) >> 6; }
    else if (kind == 1) { const int r0 = q0 >> 6; int rs0 = r0 - 4; rs0 = rs0 < 0 ? 0 : (rs0 > 56 ? 56 : rs0); int rs1 = r0 - 1; rs1 = rs1 < 0 ? 0 : (rs1 > 56 ? 56 : rs1); lt0 = rs0 * 64; nlt = rs1 + 8 - rs0; }
    else { lt0 = 0; nlt = 4; }
    const int nct = lat ? 8 : 0, ntiles = nct + nlt;
    const int nplain = lat ? nct : ntiles;
    const float* cK = isA ? P.in[I_CAK] : P.in[I_CCK]; const float* cV = isA ? P.in[I_CAV] : P.in[I_CCV]; const int HK = isA ? 4 : 12;
    const float2* rope = (const float2*)(P.ws + OFF_ROPE);
    const int skey = tid >> 3, spc = tid & 7;
    u32x4 raw[4];
#define ATT_ISSUE(ti_) do { if ((ti_) < nct) { \
            const size_t off_ = ((((size_t)b * 2 + layer) * PAST + (size_t)(ti_) * 64 + skey) * HK + kh) * 64 + spc * 8; \
            raw[0] = *(const u32x4*)(cK + off_); raw[1] = *(const u32x4*)(cK + off_ + 4); raw[2] = *(const u32x4*)(cV + off_); raw[3] = *(const u32x4*)(cV + off_ + 4); \
        } else { const int tok_ = lt0 + ((ti_) - nct) * 64 + skey; const bf16_t* rowp_ = U + (size_t)(seq_row0 + tok_) * U7W; \
            raw[0] = *(const u32x4*)(rowp_ + kcol + spc * 8); raw[1] = *(const u32x4*)(rowp_ + vcol + spc * 8); \
            if (kind == 0) raw[2] = *(const u32x4*)(rowp_ + kcol + (spc ^ 4) * 8); } } while (0)
#define ATT_COMMIT(ti_) do { bf16_t* Ks_ = KV + ((ti_) & 1) * (2 * 64 * 72); bf16_t* Vs_ = Ks_ + 64 * 72; u32x4 kw, vw; \
        if ((ti_) < nct) { \
            const f32x4 k0 = __builtin_bit_cast(f32x4, raw[0]), k1 = __builtin_bit_cast(f32x4, raw[1]), v0 = __builtin_bit_cast(f32x4, raw[2]), v1 = __builtin_bit_cast(f32x4, raw[3]); \
            kw.x = cvt_pk_bf16(k0[0], k0[1]); kw.y = cvt_pk_bf16(k0[2], k0[3]); kw.z = cvt_pk_bf16(k1[0], k1[1]); kw.w = cvt_pk_bf16(k1[2], k1[3]); \
            vw.x = cvt_pk_bf16(v0[0], v0[1]); vw.y = cvt_pk_bf16(v0[2], v0[3]); vw.z = cvt_pk_bf16(v1[0], v1[1]); vw.w = cvt_pk_bf16(v1[2], v1[3]); \
        } else { kw = raw[0]; vw = raw[1]; \
            if (kind == 0) { const u32x4 pw = raw[2]; const int tok = lt0 + ((ti_) - nct) * 64 + skey; const int rr = tok >> 6, cc = tok & 63; const bool lo = spc < 4; \
                _Pragma("unroll") for (int e = 0; e < 4; ++e) { float r2[2]; \
                    _Pragma("unroll") for (int hh = 0; hh < 2; ++hh) { const int i = (spc & 3) * 8 + 2 * e + hh; const float2 cs = (i < 16) ? rope[rr * 16 + i] : rope[cc * 16 + i - 16]; \
                        const float mine = hh ? bf_hi(kw[e]) : bf_lo(kw[e]), oth = hh ? bf_hi(pw[e]) : bf_lo(pw[e]); \
                        r2[hh] = lo ? (mine * cs.x - oth * cs.y) : (oth * cs.y + mine * cs.x); } \
                    kw[e] = cvt_pk_bf16(r2[0], r2[1]); } } } \
        *(u32x4*)(Ks_ + skey * 72 + spc * 8) = kw; *(u32x4*)(Vs_ + skey * 72 + spc * 8) = vw; } while (0)
    __syncthreads();
    ATT_ISSUE(0);
    if (kind == 1) { for (int i = tid; i < 465; i += NTHREADS) rpbs[i] = P.in[I_RPB][((size_t)layer * 12 + kh) * 465 + i]; }
    int qrow[NG], hd[NG];
    bf16x8 qf[NG][2];
    AttnSt S[NG];
#pragma unroll
    for (int g = 0; g < NG; ++g) {
        qrow[g] = isA ? q0 + wave * 16 + fr : q0 + g * 128 + wave * 16 + fr;
        hd[g] = isA ? kh * 3 + g : kh;
        const int qcol = isA ? hd[g] * 64 : 4096 + hd[g] * 64;
        const bf16_t* qp = U + (size_t)(seq_row0 + qrow[g]) * U7W + qcol + fq * 8;
        u32x4 a0 = *(const u32x4*)qp, a1 = *(const u32x4*)(qp + 32);
        if (kind == 0) {
            const int rr = qrow[g] >> 6, cc = qrow[g] & 63;
            float x1[8], x2[8];
#pragma unroll
            for (int e = 0; e < 4; ++e) { x1[2 * e] = bf_lo(a0[e]); x1[2 * e + 1] = bf_hi(a0[e]); x2[2 * e] = bf_lo(a1[e]); x2[2 * e + 1] = bf_hi(a1[e]); }
#pragma unroll
            for (int j = 0; j < 8; ++j) { const int i = fq * 8 + j; const float2 cs = (i < 16) ? rope[rr * 16 + i] : rope[cc * 16 + i - 16];
                const float o1 = x1[j] * cs.x - x2[j] * cs.y, o2 = x1[j] * cs.y + x2[j] * cs.x; x1[j] = o1; x2[j] = o2; }
#pragma unroll
            for (int e = 0; e < 4; ++e) { a0[e] = cvt_pk_bf16(x1[2 * e], x1[2 * e + 1]); a1[e] = cvt_pk_bf16(x2[2 * e], x2[2 * e + 1]); }
        }
        qf[g][0] = __builtin_bit_cast(bf16x8, a0); qf[g][1] = __builtin_bit_cast(bf16x8, a1);
        if (isA) { S[g].mrun = P.in[I_SINK][layer * 12 + hd[g]] * 1.4426950408889634f; S[g].lsum = (fq == 0) ? 1.f : 0.f; } else { S[g].mrun = -1e30f; S[g].lsum = 0.f; }
#pragma unroll
        for (int dt = 0; dt < 4; ++dt) S[g].o[dt] = (f32x4){0.f, 0.f, 0.f, 0.f};
    }
    int ti = 0;
    for (; ti < nplain; ++ti) {
        ATT_COMMIT(ti);
        __syncthreads();
        if (ti + 1 < ntiles) ATT_ISSUE(ti + 1);
        const bf16_t* Ks = KV + (ti & 1) * (2 * 64 * 72);
#pragma unroll
        for (int g = 0; g < NG; ++g) attn_tile<0>(S[g], Ks, Ks + 64 * 72, qf[g], rpbs, qrow[g], 0, fr, fq);
    }
    if (kind == 0) {
        for (; ti < ntiles; ++ti) {
            ATT_COMMIT(ti);
            __syncthreads();
            if (ti + 1 < ntiles) ATT_ISSUE(ti + 1);
            const bf16_t* Ks = KV + (ti & 1) * (2 * 64 * 72);
#pragma unroll
            for (int g = 0; g < NG; ++g) attn_tile<1>(S[g], Ks, Ks + 64 * 72, qf[g], rpbs, qrow[g], lt0 + (ti - nct) * 64, fr, fq);
        }
    } else {
        for (; ti < ntiles; ++ti) {
            ATT_COMMIT(ti);
            __syncthreads();
            if (ti + 1 < ntiles) ATT_ISSUE(ti + 1);
            const bf16_t* Ks = KV + (ti & 1) * (2 * 64 * 72);
#pragma unroll
            for (int g = 0; g < NG; ++g) attn_tile<2>(S[g], Ks, Ks + 64 * 72, qf[g], rpbs, qrow[g], lt0 + (ti - nct) * 64, fr, fq);
        }
    }
#undef ATT_ISSUE
#undef ATT_COMMIT
#pragma unroll
    for (int g = 0; g < NG; ++g) {
        float lsum = S[g].lsum;
        lsum += __shfl_xor(lsum, 16); lsum += __shfl_xor(lsum, 32);
        const float inv = 1.f / lsum;
        const int gcol = isA ? 1280 + hd[g] * 64 : 6400 + hd[g] * 64;
        bf16_t* gp = U + (size_t)(seq_row0 + qrow[g]) * U7W + gcol + fq * 4;
#pragma unroll
        for (int dt = 0; dt < 4; ++dt) { const u32x2 gw = *(const u32x2*)(gp + dt * 16);
            const float g0 = bf_lo(gw.x), g1 = bf_hi(gw.x), g2 = bf_lo(gw.y), g3 = bf_hi(gw.y);
            u32x2 ow; ow.x = cvt_pk_bf16(S[g].o[dt][0] * inv * g0 * sigmoidf_(g0), S[g].o[dt][1] * inv * g1 * sigmoidf_(g1)); ow.y = cvt_pk_bf16(S[g].o[dt][2] * inv * g2 * sigmoidf_(g2), S[g].o[dt][3] * inv * g3 * sigmoidf_(g3));
            *(u32x2*)(gp + dt * 16) = ow; }
    }
}

__device__ __forceinline__ void phase3a(const Params& P, unsigned char* smem, const int layer, const Chunk ck) {
    int tid_ = threadIdx.x; asm volatile("" : "+v"(tid_));
    const int tid = tid_;
    const int n_latC = ck.nlatb * 12 * 16, n_latA = ck.nlatb * 4 * 32, n_ctxC = ck.nctxb * 12, n_ctxA = ck.nctxb * 4 * 2;
    const int n_attn = n_latC + n_latA + n_ctxC + n_ctxA;
    const int n_tr = (ck.ntok / 64) * 8;
    for (int it = blockIdx.x; it < n_attn + n_tr; it += gridDim.x) {
        if (it < n_attn) {
            int r = it;
            if (r < n_latC) { const int b = ck.latb0 + r / 192; r %= 192; attn_item<2>(P, smem, layer, ck, 1, b, r >> 4, r & 15); }
            else if ((r -= n_latC) < n_latA) { const int b = ck.latb0 + r / 128; r %= 128; attn_item<3>(P, smem, layer, ck, 0, b, r >> 5, r & 31); }
            else if ((r -= n_latA) < n_ctxC) { attn_item<2>(P, smem, layer, ck, 3, r / 12, r % 12, 0); }
            else { r -= n_ctxC; attn_item<3>(P, smem, layer, ck, 2, r >> 3, (r >> 1) & 3, r & 1); }
        } else {
            __syncthreads();
            hy_transpose_item(P, (float*)smem, layer, ck, it - n_attn, tid);
        }
    }
}

__device__ __forceinline__ void phase3b(const Params& P, unsigned char* smem, const int layer, const Chunk ck) {
    int tid_ = threadIdx.x; asm volatile("" : "+v"(tid_));
    const int tid = tid_;
    float2* data = (float2*)smem; float2* tw = (float2*)(smem + FFT_DATA_BYTES);
    fft_init_tw(tw, tid);
    const bf16_t* T = (const bf16_t*)(P.ws + OFF_H);
    bf16_t* U = (bf16_t*)(P.ws + OFF_U7);
    const int npair = ck.nlatb / 2, nlat_items = npair * 512, nctx_items = ck.nctxb ? 512 : 0;
    const size_t nt = (size_t)ck.ntok;
    for (int it = blockIdx.x; it < nlat_items + nctx_items; it += gridDim.x) {
        const bool lat = it < nlat_items;
        const int c = lat ? (it & 511) : ((it - nlat_items) & 511);
        const int pr = lat ? (it >> 9) : 0;
        const bf16_t* tv = T + (size_t)c * nt; const bf16_t* tx1 = T + (size_t)(512 + c) * nt; const bf16_t* tx2 = T + (size_t)(1024 + c) * nt; const bf16_t* tg = T + (size_t)(1536 + c) * nt;
        const float2* sp0 = lat ? (const float2*)(P.ws + OFF_SPECL) + (size_t)c * 8192 : (const float2*)(P.ws + OFF_SPECS) + (size_t)c * 512;
        const float2* sp1 = lat ? sp0 + (size_t)512 * 8192 : sp0 + (size_t)512 * 512;
        const int spmask = lat ? 8191 : 511;
        __syncthreads();
#define HY_MAP(idx, valid, rA, rB) do { if (lat) { valid = (idx) < 4096; rA = ck.lat_row0 + pr * 8192 + (idx); rB = rA + 4096; } \
                                        else { const int q_ = (idx) >> 9, t_ = (idx) & 511; valid = t_ < 256; rA = q_ * 512 + t_; rB = rA + 256; } } while (0)
#pragma unroll
        for (int i = 0; i < 2; ++i) { const int idx = (tid + 512 * i) * 8; bool valid; int rA, rB; HY_MAP(idx, valid, rA, rB);
            float2* dp = data + PHYS(idx);
            if (valid) { const u32x4 a = *(const u32x4*)(tv + rA), bq = *(const u32x4*)(tv + rB);
#pragma unroll
                for (int e = 0; e < 4; ++e) { dp[2 * e] = make_float2(bf_lo(a[e]), bf_lo(bq[e])); dp[2 * e + 1] = make_float2(bf_hi(a[e]), bf_hi(bq[e])); } }
            else {
#pragma unroll
                for (int e = 0; e < 8; ++e) dp[e] = make_float2(0.f, 0.f); } }
        __syncthreads();
        fft_fwd_hi(data, tw, lat, tid);
        fft_mid<true>(data, sp0, nullptr, 1.f, spmask, tid);
        fft_inv_hi(data, tw, lat, tid);
#pragma unroll
        for (int i = 0; i < 2; ++i) { const int idx = (tid + 512 * i) * 8; bool valid; int rA, rB; HY_MAP(idx, valid, rA, rB);
            float2* dp = data + PHYS(idx);
            if (valid) { const u32x4 a = *(const u32x4*)(tx1 + rA), bq = *(const u32x4*)(tx1 + rB);
#pragma unroll
                for (int e = 0; e < 4; ++e) { float2 v0 = dp[2 * e], v1 = dp[2 * e + 1]; dp[2 * e] = make_float2(v0.x * bf_lo(a[e]), v0.y * bf_lo(bq[e])); dp[2 * e + 1] = make_float2(v1.x * bf_hi(a[e]), v1.y * bf_hi(bq[e])); } }
            else {
#pragma unroll
                for (int e = 0; e < 8; ++e) dp[e] = make_float2(0.f, 0.f); } }
        __syncthreads();
        fft_fwd_hi(data, tw, lat, tid);
        fft_mid<true>(data, sp1, nullptr, 1.f, spmask, tid);
        fft_inv_hi(data, tw, lat, tid);
#pragma unroll
        for (int i = 0; i < 2; ++i) { const int idx = (tid + 512 * i) * 8; bool valid; int rA, rB; HY_MAP(idx, valid, rA, rB);
            const float2* dp = data + PHYS(idx);
            if (valid) { const u32x4 xa = *(const u32x4*)(tx2 + rA), xb = *(const u32x4*)(tx2 + rB), ga = *(const u32x4*)(tg + rA), gb = *(const u32x4*)(tg + rB);
#pragma unroll
                for (int e = 0; e < 8; ++e) { const float2 v = dp[e];
                    const float x2a = (e & 1) ? bf_hi(xa[e >> 1]) : bf_lo(xa[e >> 1]), x2b = (e & 1) ? bf_hi(xb[e >> 1]) : bf_lo(xb[e >> 1]);
                    const float gA = (e & 1) ? bf_hi(ga[e >> 1]) : bf_lo(ga[e >> 1]), gB = (e & 1) ? bf_hi(gb[e >> 1]) : bf_lo(gb[e >> 1]);
                    U[(size_t)(rA + e) * U7W + 3584 + c] = f2bf(v.x * x2a * gA * sigmoidf_(gA));
                    U[(size_t)(rB + e) * U7W + 3584 + c] = f2bf(v.y * x2b * gB * sigmoidf_(gB)); } } }
#undef HY_MAP
    }
}

__device__ __forceinline__ void phase_final(const Params& P) {
    int tid_ = threadIdx.x; asm volatile("" : "+v"(tid_));
    const int tid = tid_, lane = tid & 63, wave = tid >> 6;
    const float* fw = P.in[I_FNW];
    for (int it = blockIdx.x; it < 40960 / 8; it += gridDim.x) {
        const int g = it * 8 + wave; float* x = P.out + (size_t)g * D;
        f32x4 v[8]; float ss = 0.f;
#pragma unroll
        for (int j = 0; j < 8; ++j) { v[j] = *(const f32x4*)(x + lane * 4 + 256 * j); ss += v[j][0] * v[j][0] + v[j][1] * v[j][1] + v[j][2] * v[j][2] + v[j][3] * v[j][3]; }
        const float rstd = rsqrtf(wave_sum(ss) * (1.f / D) + 1e-6f);
#pragma unroll
        for (int j = 0; j < 8; ++j) { const int k = lane * 4 + 256 * j; const f32x4 w = *(const f32x4*)(fw + k); *(f32x4*)(x + k) = v[j] * rstd * w; }
    }
}

__global__ void __launch_bounds__(NTHREADS, 2) fwd_megakernel(Params P) {
    extern __shared__ __attribute__((aligned(16))) unsigned char smem[];
    cg::grid_group grid = cg::this_grid();
#ifndef PMASK
#define PMASK 0xff
#endif
    if (PMASK & 1) phase0(P, smem);
    grid.sync();
    for (int layer = 0; layer < 2; ++layer) {
        for (int c = 0; c < 2; ++c) {
            const Chunk ck = get_chunk(c);
            if (PMASK & 2) phase1(P, smem, layer, c, ck);
            grid.sync();
            if (PMASK & 4) gemm_phase<2>((LAS unsigned char*)smem, P, layer, ck);
            grid.sync();
            if (PMASK & 8) phase3a(P, smem, layer, ck);
            grid.sync();
            if (PMASK & 16) phase3b(P, smem, layer, ck);
            grid.sync();
            if (PMASK & 32) gemm_phase<4>((LAS unsigned char*)smem, P, layer, ck);
            grid.sync();
            if (PMASK & 64) gemm_phase<5>((LAS unsigned char*)smem, P, layer, ck);
            grid.sync();
        }
    }
    if (PMASK & 128) phase_final(P);
}

extern "C" void kernel_launch(void* const* d_in, const int* in_sizes, int n_in, void* d_out, int out_size, void* d_ws, size_t ws_size, hipStream_t stream) {
    static int grid_blocks = 0;
    if (grid_blocks == 0) {
        if (n_in != 29 || ws_size < WS_END) { fprintf(stderr, "kernel_launch: need 29 inputs and %zu bytes of workspace (got %d, %zu)\n", (size_t)WS_END, n_in, ws_size); grid_blocks = -1; return; }
        int dev = 0, cus = 0, per_cu = 0;
        hipGetDevice(&dev);
        hipDeviceGetAttribute(&cus, hipDeviceAttributeMultiprocessorCount, dev);
        if (hipFuncSetAttribute((const void*)fwd_megakernel, hipFuncAttributeMaxDynamicSharedMemorySize, LDS_BYTES) != hipSuccess) { fprintf(stderr, "kernel_launch: hipFuncSetAttribute failed\n"); grid_blocks = -1; return; }
        hipOccupancyMaxActiveBlocksPerMultiprocessor(&per_cu, (const void*)fwd_megakernel, NTHREADS, LDS_BYTES);
        if (per_cu < 1) per_cu = 1;
        grid_blocks = cus * per_cu;
        (void)hipGetLastError();
    }
    if (grid_blocks < 0) return;
    Params p{};
    for (int i = 0; i < 29; ++i) p.in[i] = (const float*)d_in[i];
    p.out = (float*)d_out; p.ws = (unsigned char*)d_ws;
    void* args[] = {&p};
    hipError_t e = hipLaunchCooperativeKernel((const void*)fwd_megakernel, dim3(grid_blocks), dim3(NTHREADS), args, LDS_BYTES, stream);
    if (e != hipSuccess) fprintf(stderr, "cooperative launch failed: %s (grid %d)\n", hipGetErrorString(e), grid_blocks);
}
```

```cpp
#include <hip/hip_runtime.h>
#include <hip/hip_cooperative_groups.h>
#include <cstdio>
#include <cstdint>
namespace cg = cooperative_groups;

#define LAS __attribute__((address_space(3)))
typedef unsigned short bf16_t;
typedef short bf16x8 __attribute__((ext_vector_type(8)));
typedef float f32x4 __attribute__((ext_vector_type(4)));
typedef unsigned u32x4 __attribute__((ext_vector_type(4)));
typedef unsigned u32x2 __attribute__((ext_vector_type(2)));

constexpr int D = 2048, NCTXTOK = 8192, LLAT = 4096, LCTX = 256, PAST = 512;
constexpr int INW = 13312, U7W = 7168, MGW = 6144;
constexpr int NTHREADS = 512;
constexpr int LDS_BYTES = 131072;
constexpr size_t OUT_AK = 83886080ull, OUT_AV = 88080384ull, OUT_CK = 92274688ull, OUT_CV = 104857600ull;
constexpr size_t OFF_MOD = 4096;
constexpr size_t OFF_ROPE = OFF_MOD + 2ull * 9 * 6144 * 4;
constexpr size_t OFF_Z2 = OFF_ROPE + 8192;
constexpr size_t OFF_WTIN = OFF_Z2 + 2ull * 4352 * 64 * 4;
constexpr size_t OFF_WTUP = OFF_WTIN + 13312ull * 2048 * 2;
constexpr size_t OFF_WTOUT = OFF_WTUP + 2048ull * 2048 * 2;
constexpr size_t OFF_SPECL = OFF_WTOUT + 2048ull * 2048 * 2;
constexpr size_t OFF_SPECS = OFF_SPECL + 2ull * 512 * 8192 * 8;
constexpr size_t OFF_H = OFF_SPECS + 2ull * 512 * 512 * 8;
constexpr size_t OFF_U7 = OFF_H + 24576ull * 2048 * 2;
constexpr size_t OFF_MG = OFF_U7 + 24576ull * 7168 * 2;
constexpr size_t OFF_HFL = OFF_MG + 24576ull * 6144 * 2;
constexpr size_t OFF_HFS = OFF_HFL + 2ull * 2 * 512 * 2 * 4096 * 4;
constexpr size_t WS_END = OFF_HFS + 2ull * 2 * 512 * 2 * 256 * 4;

struct Params { const float* in[29]; float* out; unsigned char* ws; };
enum { I_XP = 0, I_XS, I_C, I_CAK, I_CAV, I_CCK, I_CCV, I_CCTX, I_NW, I_WADA, I_BADA, I_WIN, I_SINK, I_HCW, I_HCB, I_HW1, I_HB1, I_HW2, I_HB2,
       I_HFREQ, I_HW3, I_HDEC, I_HSKIP, I_RPB, I_WUA, I_WUB, I_WUC, I_WOUT, I_FNW };

struct Chunk { int tok0, ntok, nctxb, lat_row0, latb0, nlatb; };
__device__ __forceinline__ Chunk get_chunk(int c) { Chunk k; if (c == 0) { k.tok0 = 0; k.ntok = 24576; k.nctxb = 32; k.lat_row0 = 8192; k.latb0 = 0; k.nlatb = 4; } else { k.tok0 = 24576; k.ntok = 16384; k.nctxb = 0; k.lat_row0 = 0; k.latb0 = 4; k.nlatb = 4; } return k; }
__device__ __forceinline__ int cond_of(int g) { return g < NCTXTOK ? 0 : 1 + ((g - NCTXTOK) >> 12); }

__device__ __forceinline__ unsigned cvt_pk_bf16(float lo, float hi) { unsigned r; asm volatile("v_cvt_pk_bf16_f32 %0, %1, %2" : "=v"(r) : "v"(lo), "v"(hi)); return r; }
__device__ __forceinline__ float bf_lo(unsigned u) { return __uint_as_float(u << 16); }
__device__ __forceinline__ float bf_hi(unsigned u) { return __uint_as_float(u & 0xffff0000u); }
__device__ __forceinline__ float bf2f(bf16_t b) { return __uint_as_float(((unsigned)b) << 16); }
__device__ __forceinline__ bf16_t f2bf(float f) { return (bf16_t)(cvt_pk_bf16(f, 0.f) & 0xffffu); }
__device__ __forceinline__ float wave_sum(float v) {
#pragma unroll
    for (int o = 1; o < 64; o <<= 1) v += __shfl_xor(v, o);
    return v;
}
__device__ __forceinline__ float sigmoidf_(float x) { return __builtin_amdgcn_rcpf(1.f + __expf(-x)); }

constexpr int BM = 256, BK = 64, HALF = 128, HTB = HALF * BK * 2;
__device__ __forceinline__ int lds_byte(int r, int c) { const int st = (r >> 4) * 2 + (c >> 5), rr = r & 15, cc = c & 31, ob = rr * 64 + cc * 2; return st * 1024 + (ob ^ (((ob >> 9) & 1) << 5)); }
__device__ __forceinline__ void stage_rc(int b, int& R, int& C) { const int st = b / 1024, sb = b % 1024, swz = sb ^ (((sb >> 9) & 1) << 5); R = (st >> 1) * 16 + swz / 64; C = (st & 1) * 32 + (swz % 64) / 2; }
__device__ __forceinline__ int perm32(int rho) { const int n = rho >> 4, i = rho & 15; return 8 * (i >> 2) + 4 * n + (i & 3); }

struct GSched { int nM, nN, ntile, G, c; };
template <int PER>
__device__ __forceinline__ bool gs_next(const GSched& S, int ui, int& pm, int& pn, int& br) {
    const int round = ui / PER; br = ui - round * PER;
    const long L = (long)round * S.G + S.c; if (L >= S.ntile) return false;
    int wgid = (int)L; { const int q = S.ntile / 8, r = S.ntile % 8, xcd = wgid % 8, off = wgid / 8; wgid = (xcd < r ? xcd * (q + 1) : r * (q + 1) + (xcd - r) * q) + off; }
    const int nig = 8 * S.nN, gid = wgid / nig, fm = gid * 8, gsz = (S.nM - fm) < 8 ? (S.nM - fm) : 8;
    pm = fm + ((wgid % nig) % gsz); pn = (wgid % nig) / gsz; return true;
}

template <int MODE>
__device__ __forceinline__ void gemm_phase(LAS unsigned char* lds, const Params& P, const int layer, const Chunk ck) {
    constexpr bool PERM = (MODE != 5);
    constexpr int PER = (MODE == 4) ? 3 : 1;
    int tid_ = threadIdx.x; asm volatile("" : "+v"(tid_));
    const int tid = tid_, wid = __builtin_amdgcn_readfirstlane(tid >> 6), lane = tid & 63, wr = wid >> 2, wc = wid & 3, fr = lane & 15, fq = lane >> 4;
    const char* Abase; const char* Bbase; unsigned lda, ldb; int nN;
    if (MODE == 2) { Abase = (const char*)(P.ws + OFF_H); lda = 4096u; Bbase = (const char*)(P.ws + OFF_WTIN); ldb = 4096u; nN = 52; }
    else if (MODE == 4) { Abase = (const char*)(P.ws + OFF_U7); lda = 14336u; Bbase = (const char*)(P.ws + OFF_WTUP); ldb = 4096u; nN = 8; }
    else { Abase = (const char*)(P.ws + OFF_H); lda = 4096u; Bbase = (const char*)(P.ws + OFF_WTOUT); ldb = 4096u; nN = 8; }
    GSched S; S.nM = ck.ntok / 256; S.nN = nN; S.ntile = S.nM * nN; S.G = (int)gridDim.x; S.c = (int)blockIdx.x;
    unsigned voffA[2], voffB[2];
#pragma unroll
    for (int i = 0; i < 2; ++i) { int R, C; stage_rc(tid * 16 + i * 8192, R, C); const int Rb = PERM ? ((R & ~31) + perm32(R & 31)) : R;
        voffA[i] = (unsigned)R * lda + (unsigned)C * 2u; voffB[i] = (unsigned)Rb * ldb + (unsigned)C * 2u; }
    const size_t kstep = (size_t)(BK * 2);
    const size_t hstepA = (size_t)HALF * lda, hstepB = (size_t)HALF * ldb;
    const unsigned ldsw = (unsigned)wid * 1024u;
    const int aoff = lds_byte(wr * 64 + fr, fq * 8), boff = lds_byte(wc * 32 + fr, fq * 8);
#define PG8_SA(b, h) (((b) * 2 + (h)) * HTB)
#define PG8_SB(b, h) ((4 + (b) * 2 + (h)) * HTB)
#define PG8_STAGE(bufoff, gbase, voff) do { _Pragma("unroll") for (int _i = 0; _i < 2; ++_i) \
        __builtin_amdgcn_global_load_lds((const unsigned*)((const char*)(gbase) + (voff)[_i]), (LAS unsigned*)(lds + (bufoff) + ldsw + _i * 8192), 16, 0, 0); } while (0)
#define PG8_LDA(dst, b, h) do { _Pragma("unroll") for (int m = 0; m < 4; ++m) _Pragma("unroll") for (int k = 0; k < 2; ++k) dst[m][k] = *(const LAS bf16x8*)(lds + PG8_SA(b, h) + aoff + m * 2048 + k * 1024); } while (0)
#define PG8_LDB(dst, b, h) do { _Pragma("unroll") for (int n = 0; n < 2; ++n) _Pragma("unroll") for (int k = 0; k < 2; ++k) dst[n][k] = *(const LAS bf16x8*)(lds + PG8_SB(b, h) + boff + n * 2048 + k * 1024); } while (0)
#define PG8_MMA(ai, bj, At, Bt) do { __builtin_amdgcn_s_setprio(1); _Pragma("unroll") for (int m = 0; m < 4; ++m) _Pragma("unroll") for (int n = 0; n < 2; ++n) _Pragma("unroll") for (int k = 0; k < 2; ++k) \
        acc[ai][bj][m][n] = __builtin_amdgcn_mfma_f32_16x16x32_bf16(Bt[n][k], At[m][k], acc[ai][bj][m][n], 0, 0, 0); __builtin_amdgcn_s_setprio(0); } while (0)
#define PG8_WAIT_V(n) asm volatile("s_waitcnt vmcnt(" #n ")" ::: "memory")
#define PG8_WAIT_L(n) asm volatile("s_waitcnt lgkmcnt(" #n ")" ::: "memory")
#define PG8_BAR __builtin_amdgcn_s_barrier()
#define PG8_SCHED __builtin_amdgcn_sched_barrier(0)
#define UNIT_PTRS(pm_, pn_, br_, a_, b_, nt_) do { \
        if (MODE == 4) { const int acol = (br_) == 0 ? 1280 : ((br_) == 1 ? 3584 : 6400), bk = (br_) == 0 ? 0 : ((br_) == 1 ? 768 : 1280); nt_ = (br_) == 1 ? 8 : 12; \
            a_ = Abase + (size_t)(pm_) * 256 * lda + (size_t)acol * 2; b_ = Bbase + (size_t)(pn_) * 256 * ldb + (size_t)bk * 2; } \
        else { nt_ = 32; a_ = Abase + (size_t)(pm_) * 256 * lda; b_ = Bbase + (size_t)(pn_) * 256 * ldb; } } while (0)
    int pm, pn, br, npm, npn, nbr; int ui = 0;
    if (!gs_next<PER>(S, 0, pm, pn, br)) return;
    f32x4 acc[2][2][4][2];
#pragma unroll
    for (int a = 0; a < 2; ++a)
#pragma unroll
        for (int b = 0; b < 2; ++b)
#pragma unroll
            for (int m = 0; m < 4; ++m)
#pragma unroll
                for (int n = 0; n < 2; ++n) acc[a][b][m][n] = (f32x4){0.f, 0.f, 0.f, 0.f};
    bf16x8 At[4][2], B0[2][2], B1[2][2];
    const char* cA; const char* cB; int nt;
    UNIT_PTRS(pm, pn, br, cA, cB, nt);
    PG8_STAGE(PG8_SB(0, 0), cB, voffB); PG8_STAGE(PG8_SB(0, 1), cB + hstepB, voffB); PG8_STAGE(PG8_SA(0, 0), cA, voffA); PG8_STAGE(PG8_SA(0, 1), cA + hstepA, voffA);
    if (wr == 1) PG8_BAR;
    PG8_WAIT_V(2); PG8_BAR;
    PG8_STAGE(PG8_SB(1, 0), cB + kstep, voffB); PG8_STAGE(PG8_SA(1, 0), cA + kstep, voffA); PG8_STAGE(PG8_SB(1, 1), cB + hstepB + kstep, voffB);
    PG8_WAIT_V(6); PG8_BAR;
    for (;;) {
        const bool has_next = gs_next<PER>(S, ui + 1, npm, npn, nbr);
        const char* nA = cA; const char* nB = cB; int nnt = nt;
        if (has_next) { UNIT_PTRS(npm, npn, nbr, nA, nB, nnt); }
        for (int t = 0; t < nt; t += 2) {
            const bool last = (t == nt - 2);
            const char* a1 = cA + (size_t)(t + 1) * kstep;
            const char* a2 = last ? nA : cA + (size_t)(t + 2) * kstep; const char* b2 = last ? nB : cB + (size_t)(t + 2) * kstep;
            const char* a3 = a2 + kstep; const char* b3 = b2 + kstep;
            PG8_LDB(B0, 0, 0); PG8_LDB(B1, 0, 1); PG8_SCHED; PG8_LDA(At, 0, 0); PG8_STAGE(PG8_SA(1, 1), a1 + hstepA, voffA);
            PG8_WAIT_V(8); PG8_WAIT_L(0); PG8_BAR; PG8_MMA(0, 0, At, B0); PG8_MMA(0, 1, At, B1); PG8_BAR; PG8_SCHED;
            PG8_LDA(At, 0, 1); PG8_STAGE(PG8_SB(0, 0), b2, voffB); PG8_STAGE(PG8_SB(0, 1), b2 + hstepB, voffB); PG8_STAGE(PG8_SA(0, 0), a2, voffA);
            PG8_WAIT_V(8); PG8_WAIT_L(0); PG8_BAR; PG8_MMA(1, 0, At, B0); PG8_MMA(1, 1, At, B1); PG8_BAR; PG8_SCHED;
            PG8_LDB(B0, 1, 0); PG8_LDB(B1, 1, 1); PG8_SCHED; PG8_LDA(At, 1, 0); PG8_STAGE(PG8_SA(0, 1), a2 + hstepA, voffA);
            PG8_WAIT_V(8); PG8_WAIT_L(0); PG8_BAR; PG8_MMA(0, 0, At, B0); PG8_MMA(0, 1, At, B1); PG8_BAR; PG8_SCHED;
            PG8_LDA(At, 1, 1); PG8_STAGE(PG8_SB(1, 0), b3, voffB); PG8_STAGE(PG8_SB(1, 1), b3 + hstepB, voffB); PG8_STAGE(PG8_SA(1, 0), a3, voffA);
            PG8_WAIT_V(8); PG8_WAIT_L(0); PG8_BAR; PG8_MMA(1, 0, At, B0); PG8_MMA(1, 1, At, B1); PG8_BAR; PG8_SCHED;
        }
        if (wr == 0) PG8_BAR;
        {
            const int row0 = pm * BM + wr * 64 + fr;
            if (MODE == 2) {
                const int colt = pn * BM + wc * 32 + 8 * fq;
                const bool isu = pn < 28;
                bf16_t* dst = isu ? (bf16_t*)(P.ws + OFF_U7) + colt : (bf16_t*)(P.ws + OFF_MG) + (colt - U7W);
                const int ldd = isu ? U7W : MGW;
                float* kvo = nullptr; int kvw = 0, kvc = 0;
                if (ck.tok0 + pm * BM < NCTXTOK) {
                    if (pn == 3) { kvo = P.out + OUT_AK; kvw = 256; kvc = colt - 768; }
                    else if (pn == 4) { kvo = P.out + OUT_AV; kvw = 256; kvc = colt - 1024; }
                    else if (pn >= 19 && pn < 22) { kvo = P.out + OUT_CK; kvw = 768; kvc = colt - 4864; }
                    else if (pn >= 22 && pn < 25) { kvo = P.out + OUT_CV; kvw = 768; kvc = colt - 5632; }
                }
#pragma unroll
                for (int ai = 0; ai < 2; ++ai)
#pragma unroll
                    for (int m = 0; m < 4; ++m) {
                        const int r = row0 + ai * HALF + m * 16;
#pragma unroll
                        for (int bj = 0; bj < 2; ++bj) {
                            const f32x4 v0 = acc[ai][bj][m][0], v1 = acc[ai][bj][m][1];
                            u32x4 w; w.x = cvt_pk_bf16(v0[0], v0[1]); w.y = cvt_pk_bf16(v0[2], v0[3]); w.z = cvt_pk_bf16(v1[0], v1[1]); w.w = cvt_pk_bf16(v1[2], v1[3]);
                            *(u32x4*)(dst + (size_t)r * ldd + bj * HALF) = w;
                            if (kvo) { const int g = ck.tok0 + r; const int bb = g >> 8, s = g & 255;
                                float* o = kvo + ((size_t)(bb * 2 + layer) * 256 + s) * kvw + kvc + bj * HALF;
                                *(f32x4*)o = v0; *(f32x4*)(o + 4) = v1; }
                        }
                    }
            } else if (MODE == 4) {
                const int colt = pn * BM + wc * 32 + 8 * fq;
                const bf16_t* mg = (const bf16_t*)(P.ws + OFF_MG) + (br == 0 ? 0 : (br == 1 ? 2048 : 4096));
                bf16_t* mo = (bf16_t*)(P.ws + OFF_H);
#pragma unroll
                for (int ai = 0; ai < 2; ++ai)
#pragma unroll
                  for (int mh = 0; mh < 2; ++mh) {
                    u32x4 ga[2][2], gb[2][2];
#pragma unroll
                    for (int ml = 0; ml < 2; ++ml)
#pragma unroll
                        for (int bj = 0; bj < 2; ++bj) { const bf16_t* mr = mg + (size_t)(row0 + ai * HALF + (mh * 2 + ml) * 16) * MGW + colt + bj * HALF;
                            ga[ml][bj] = *(const u32x4*)mr; if (br != 2) gb[ml][bj] = *(const u32x4*)(mr + 2048); }
#pragma unroll
                    for (int ml = 0; ml < 2; ++ml) {
                        const int m = mh * 2 + ml;
                        const int r = row0 + ai * HALF + m * 16;
#pragma unroll
                        for (int bj = 0; bj < 2; ++bj) {
                            const int c0 = colt + bj * HALF;
                            float f[8];
#pragma unroll
                            for (int e = 0; e < 4; ++e) {
                                const float d0 = __builtin_amdgcn_rcpf(1.f + __expf(-bf_lo(ga[ml][bj][e]))), d1 = __builtin_amdgcn_rcpf(1.f + __expf(-bf_hi(ga[ml][bj][e])));
                                if (br != 2) { f[2 * e] = (1.f + __expf(-bf_lo(gb[ml][bj][e]))) * d0; f[2 * e + 1] = (1.f + __expf(-bf_hi(gb[ml][bj][e]))) * d1; }
                                else { f[2 * e] = d0; f[2 * e + 1] = d1; } }
                            f32x4 v0 = acc[ai][bj][m][0], v1 = acc[ai][bj][m][1];
                            v0[0] *= f[0]; v0[1] *= f[1]; v0[2] *= f[2]; v0[3] *= f[3]; v1[0] *= f[4]; v1[1] *= f[5]; v1[2] *= f[6]; v1[3] *= f[7];
                            if (br == 2) { u32x4 w; w.x = cvt_pk_bf16(v0[0], v0[1]); w.y = cvt_pk_bf16(v0[2], v0[3]); w.z = cvt_pk_bf16(v1[0], v1[1]); w.w = cvt_pk_bf16(v1[2], v1[3]);
                                *(u32x4*)(mo + (size_t)r * D + c0) = w; v0 = (f32x4){0.f, 0.f, 0.f, 0.f}; v1 = v0; }
                            acc[ai][bj][m][0] = v0; acc[ai][bj][m][1] = v1;
                        }
                    }
                  }
            } else {
                const int colt = pn * BM + wc * 32 + 4 * fq;
                const int g0 = ck.tok0 + pm * BM;
                const float* gt = (const float*)(P.ws + OFF_MOD) + ((size_t)layer * 9 + cond_of(g0)) * 6144 + 4096 + colt;
                f32x4 gv[2][2];
#pragma unroll
                for (int bj = 0; bj < 2; ++bj)
#pragma unroll
                    for (int n = 0; n < 2; ++n) gv[bj][n] = *(const f32x4*)(gt + bj * HALF + n * 16);
#pragma unroll
                for (int ai = 0; ai < 2; ++ai)
#pragma unroll
                    for (int mh = 0; mh < 2; ++mh) {
                        f32x4 xv[2][2][2];
#pragma unroll
                        for (int ml = 0; ml < 2; ++ml) { const int g = ck.tok0 + row0 + ai * HALF + (mh * 2 + ml) * 16;
                            const float* xo = (layer == 0) ? (g < NCTXTOK ? P.in[I_XP] + (size_t)g * D : P.in[I_XS] + (size_t)(g - NCTXTOK) * D) : P.out + (size_t)g * D;
#pragma unroll
                            for (int bj = 0; bj < 2; ++bj)
#pragma unroll
                                for (int n = 0; n < 2; ++n) xv[ml][bj][n] = *(const f32x4*)(xo + colt + bj * HALF + n * 16); }
#pragma unroll
                        for (int ml = 0; ml < 2; ++ml) { const int m = mh * 2 + ml; const int g = ck.tok0 + row0 + ai * HALF + m * 16; float* yo = P.out + (size_t)g * D + colt;
#pragma unroll
                            for (int bj = 0; bj < 2; ++bj)
#pragma unroll
                                for (int n = 0; n < 2; ++n) *(f32x4*)(yo + bj * HALF + n * 16) = xv[ml][bj][n] + gv[bj][n] * acc[ai][bj][m][n]; }
                    }
            }
        }
        if (!has_next) break;
        if (MODE != 4) {
#pragma unroll
            for (int a = 0; a < 2; ++a)
#pragma unroll
                for (int b = 0; b < 2; ++b)
#pragma unroll
                    for (int m = 0; m < 4; ++m)
#pragma unroll
                        for (int n = 0; n < 2; ++n) acc[a][b][m][n] = (f32x4){0.f, 0.f, 0.f, 0.f};
        }
        pm = npm; pn = npn; br = nbr; cA = nA; cB = nB; nt = nnt; ++ui;
        if (wr == 1) PG8_BAR;
    }
    PG8_WAIT_V(0);
    PG8_BAR;
#undef PG8_SA
#undef PG8_SB
#undef PG8_STAGE
#undef PG8_LDA
#undef PG8_LDB
#undef PG8_MMA
#undef PG8_WAIT_V
#undef PG8_WAIT_L
#undef PG8_BAR
#undef PG8_SCHED
#undef UNIT_PTRS
}

#define PHYS(i) ((i) + ((i) >> 4))
constexpr int FFT_DATA_BYTES = (8192 + 512) * 8;
__device__ __forceinline__ float2 cmul(float2 a, float2 b) { return make_float2(a.x * b.x - a.y * b.y, a.x * b.y + a.y * b.x); }
__device__ __forceinline__ float2 cmulc(float2 a, float2 b) { return make_float2(a.x * b.x + a.y * b.y, a.y * b.x - a.x * b.y); }
__device__ __forceinline__ float2 root16(int n) {
    const float c1 = 0.92387953251128674f, s1 = 0.38268343236508977f, h = 0.70710678118654752f;
    switch (n) { case 0: return make_float2(1.f, 0.f); case 1: return make_float2(c1, -s1); case 2: return make_float2(h, -h); case 3: return make_float2(s1, -c1);
                 case 4: return make_float2(0.f, -1.f); case 5: return make_float2(-s1, -c1); case 6: return make_float2(-h, -h); default: return make_float2(-c1, -s1); }
}
template <int R, bool INV, bool TW>
__device__ __forceinline__ void fft_regs(float2 (&x)[1 << R], const float2 (&w)[R]) {
    constexpr int NP = 1 << R;
    if (!INV) {
#pragma unroll
        for (int s = 0; s < R; ++s) { const int h = 1 << (R - 1 - s);
#pragma unroll
            for (int k = 0; k < NP; ++k) if (!(k & h)) { const int q = k & (h - 1);
                const float2 a = x[k], b = x[k + h]; x[k] = make_float2(a.x + b.x, a.y + b.y);
                float2 t = make_float2(a.x - b.x, a.y - b.y); if (TW) t = cmul(t, w[s]); x[k + h] = cmul(t, root16(q * (8 / h))); } }
    } else {
#pragma unroll
        for (int s = R - 1; s >= 0; --s) { const int h = 1 << (R - 1 - s);
#pragma unroll
            for (int k = 0; k < NP; ++k) if (!(k & h)) { const int q = k & (h - 1);
                const float2 a = x[k]; float2 b = cmulc(x[k + h], root16(q * (8 / h))); if (TW) b = cmulc(b, w[s]);
                x[k] = make_float2(a.x + b.x, a.y + b.y); x[k + h] = make_float2(a.x - b.x, a.y - b.y); } }
    }
}
template <int S, int R, bool INV>
__device__ __forceinline__ void fft_pass(float2* d, const float2* tw, int tid) {
    constexpr int NP = 1 << R, GPT = (8192 >> R) / NTHREADS;
#pragma unroll
    for (int g = 0; g < GPT; ++g) {
        const int gid = tid + NTHREADS * g, r = gid & (S - 1), base = (gid / S) * (S << R) + r;
        float2 x[NP], w[R];
#pragma unroll
        for (int k = 0; k < NP; ++k) x[k] = d[PHYS(base + k * S)];
        w[0] = tw[r * (8192 / (S << R))];
#pragma unroll
        for (int s = 1; s < R; ++s) w[s] = cmul(w[s - 1], w[s - 1]);
        fft_regs<R, INV, true>(x, w);
#pragma unroll
        for (int k = 0; k < NP; ++k) d[PHYS(base + k * S)] = x[k];
    }
    __syncthreads();
}
__device__ __forceinline__ void fft_fwd_hi(float2* d, const float2* tw, bool lng, int tid) {
    if (lng) fft_pass<512, 4, false>(d, tw, tid);
    fft_pass<128, 2, false>(d, tw, tid);
    fft_pass<16, 3, false>(d, tw, tid);
}
__device__ __forceinline__ void fft_inv_hi(float2* d, const float2* tw, bool lng, int tid) {
    fft_pass<16, 3, true>(d, tw, tid);
    fft_pass<128, 2, true>(d, tw, tid);
    if (lng) fft_pass<512, 4, true>(d, tw, tid);
}
template <bool CONV>
__device__ __forceinline__ void fft_mid(float2* d, const float2* spec_in, float2* spec_out, float scale, int spmask, int tid) {
    float2 x[16]; const float2 w[4] = {make_float2(1.f, 0.f), make_float2(1.f, 0.f), make_float2(1.f, 0.f), make_float2(1.f, 0.f)};
    float2* p = d + 17 * tid;
#pragma unroll
    for (int k = 0; k < 16; ++k) x[k] = p[k];
    fft_regs<4, false, false>(x, w);
    if (CONV) {
        const f32x4* sp = (const f32x4*)(spec_in + ((16 * tid) & spmask));
#pragma unroll
        for (int k2 = 0; k2 < 8; ++k2) { const f32x4 sv = sp[k2]; x[2 * k2] = cmul(x[2 * k2], make_float2(sv[0], sv[1])); x[2 * k2 + 1] = cmul(x[2 * k2 + 1], make_float2(sv[2], sv[3])); }
        fft_regs<4, true, false>(x, w);
#pragma unroll
        for (int k = 0; k < 16; ++k) p[k] = x[k];
    } else {
        f32x4* so = (f32x4*)(spec_out + 16 * tid);
#pragma unroll
        for (int k2 = 0; k2 < 8; ++k2) so[k2] = (f32x4){x[2 * k2].x * scale, x[2 * k2].y * scale, x[2 * k2 + 1].x * scale, x[2 * k2 + 1].y * scale};
    }
    __syncthreads();
}
__device__ __forceinline__ void fft_init_tw(float2* tw, int tid) {
    for (int k = tid; k < 4096; k += NTHREADS) { float s, c; sincospif((float)k * (1.f / 4096.f), &s, &c); tw[k] = make_float2(c, -s); }
    __syncthreads();
}

__device__ __forceinline__ void phase0(const Params& P, unsigned char* smem) {
    int tid_ = threadIdx.x; asm volatile("" : "+v"(tid_));
    const int tid = tid_, lane = tid & 63, wave = tid >> 6;
    for (int it = blockIdx.x; it < 192 + 1 + 136; it += gridDim.x) {
        __syncthreads();
        if (it < 192) {
            const int l = it / 96, col0 = (it % 96) * 64;
            float* s = (float*)smem; float* red = (float*)(smem + 9 * 2048 * 4);
            for (int i = tid; i < 9 * 2048; i += NTHREADS) { const int v = i >> 11, k = i & 2047; const float x = (v == 0) ? P.in[I_CCTX][k] : P.in[I_C][(v - 1) * 2048 + k]; s[i] = x / (1.f + expf(-x)); }
            __syncthreads();
            const int kg = tid >> 4, cj = tid & 15;
            float acc[9][4];
#pragma unroll
            for (int v = 0; v < 9; ++v) { acc[v][0] = 0.f; acc[v][1] = 0.f; acc[v][2] = 0.f; acc[v][3] = 0.f; }
            const float* wp = P.in[I_WADA] + (size_t)l * 2048 * 6144 + col0 + 4 * cj;
#pragma unroll 4
            for (int k = kg; k < 2048; k += 32) { const f32x4 w = *(const f32x4*)(wp + (size_t)k * 6144);
#pragma unroll
                for (int v = 0; v < 9; ++v) { const float sv = s[v * 2048 + k]; acc[v][0] += sv * w[0]; acc[v][1] += sv * w[1]; acc[v][2] += sv * w[2]; acc[v][3] += sv * w[3]; } }
#pragma unroll
            for (int v = 0; v < 9; ++v)
#pragma unroll
                for (int e = 0; e < 4; ++e) { float a = acc[v][e]; a += __shfl_xor(a, 16); a += __shfl_xor(a, 32); acc[v][e] = a; }
            if (lane < 16) {
#pragma unroll
                for (int v = 0; v < 9; ++v)
#pragma unroll
                    for (int e = 0; e < 4; ++e) red[(wave * 16 + cj) * 36 + v * 4 + e] = acc[v][e];
            }
            __syncthreads();
            for (int i = tid; i < 9 * 64; i += NTHREADS) { const int v = i >> 6, cc = i & 63; float a = P.in[I_BADA][l * 6144 + col0 + cc];
                for (int w = 0; w < 8; ++w) a += red[(w * 16 + (cc >> 2)) * 36 + v * 4 + (cc & 3)];
                ((float*)(P.ws + OFF_MOD))[((size_t)l * 9 + v) * 6144 + col0 + cc] = a; }
        } else if (it == 192) {
            float2* tab = (float2*)(P.ws + OFF_ROPE);
            for (int i = tid; i < 1024; i += NTHREADS) { const int pos = i >> 4, f = i & 15; const float inv = powf(10000.f, -(float)f / 16.f); const float ang = (float)pos * inv; tab[i] = make_float2(cosf(ang), sinf(ang)); }
        } else {
            const int j = it - 193, l = j / 68, tb = j % 68;
            const bool lng = tb < 64; const int t0 = lng ? tb * 64 : (tb - 64) * 64; const float invL = lng ? (1.f / 4096.f) : (1.f / 256.f);
            const int rowoff = l * 4352 + (lng ? 0 : 4096) + t0;
            float* feats = (float*)smem; float* z1 = feats + 64 * 33;
            for (int i = tid; i < 64 * 33; i += NTHREADS) { const int tl = i / 33, f = i % 33; const float t = (float)(t0 + tl) * invL;
                float v; if (f == 0) v = t; else if (f <= 16) v = sinpif(2.f * (float)f * t); else v = cospif(2.f * (float)(f - 16) * t); feats[i] = v; }
            __syncthreads();
            const int tl = tid >> 3, part = tid & 7;
            const float* w1 = P.in[I_HW1] + (size_t)l * 33 * 64; const float* b1 = P.in[I_HB1] + l * 64; const float* fr0 = P.in[I_HFREQ] + l * 128;
            for (int jj = 0; jj < 8; ++jj) { const int jo = part * 8 + jj; float a = b1[jo];
                for (int f = 0; f < 33; ++f) a += feats[tl * 33 + f] * w1[f * 64 + jo];
                z1[tl * 65 + jo] = sinf(fr0[jo] * a); }
            __syncthreads();
            const float* w2 = P.in[I_HW2] + (size_t)l * 64 * 64; const float* b2 = P.in[I_HB2] + l * 64; const float* fr1 = fr0 + 64;
            float* z2 = (float*)(P.ws + OFF_Z2);
            for (int jj = 0; jj < 8; ++jj) { const int jo = part * 8 + jj; float a = b2[jo];
                for (int f = 0; f < 64; ++f) a += z1[tl * 65 + f] * w2[f * 64 + jo];
                z2[(size_t)(rowoff + tl) * 64 + jo] = sinf(fr1[jo] * a); }
        }
    }
}


__device__ __forceinline__ void phase0b(const Params& P, unsigned char* smem) {
    int tid_ = threadIdx.x; asm volatile("" : "+v"(tid_));
    const int tid = tid_;
    float* w3s = (float*)smem;
    for (int it = blockIdx.x; it < 2 * 2 * 16 * 9; it += gridDim.x) {
        const int tb = it % 9, cg = (it / 9) & 15, o = (it / 144) & 1, l = it / 288;
        const bool lng = tb < 8;
        __syncthreads();
        const float* w3 = P.in[I_HW3] + (size_t)l * 64 * 2048;
        for (int i = tid; i < 4096; i += NTHREADS) { const int j = i >> 6, cc = i & 63; w3s[i] = w3[j * 2048 + o * 1024 + (cc >> 5) * 512 + cg * 32 + (cc & 31)]; }
        __syncthreads();
        if (lng || tid < 256) {
            const int t = lng ? tb * 512 + tid : tid;
            const float tt = lng ? (float)t * (1.f / 4096.f) : (float)t * (1.f / 256.f);
            const f32x4* zr = (const f32x4*)((const float*)(P.ws + OFF_Z2) + ((size_t)l * 4352 + (lng ? t : 4096 + t)) * 64);
            float acc[64];
#pragma unroll
            for (int cc = 0; cc < 64; ++cc) acc[cc] = 0.f;
#pragma unroll 1
            for (int j4 = 0; j4 < 16; ++j4) { const f32x4 z = zr[j4];
#pragma unroll
                for (int e = 0; e < 4; ++e) { const f32x4* wr = (const f32x4*)(w3s + (j4 * 4 + e) * 64);
#pragma unroll
                    for (int c4 = 0; c4 < 16; ++c4) { const f32x4 w = wr[c4]; acc[4 * c4] += z[e] * w[0]; acc[4 * c4 + 1] += z[e] * w[1]; acc[4 * c4 + 2] += z[e] * w[2]; acc[4 * c4 + 3] += z[e] * w[3]; } } }
            const float* dec = P.in[I_HDEC] + l * 2048 + o * 1024;
            const float* skp = P.in[I_HSKIP] + l * 1024 + o * 512;
#pragma unroll
            for (int cc = 0; cc < 64; ++cc) { const int d = cc >> 5, c = cg * 32 + (cc & 31);
                float v = acc[cc] * expf(-fabsf(dec[d * 512 + c]) * tt);
                if (d == 0 && t == 0) v += skp[c];
                const size_t fi = (((size_t)(l * 2 + o) * 512 + c) * 2 + d);
                if (lng) ((float*)(P.ws + OFF_HFL))[fi * 4096 + t] = v; else ((float*)(P.ws + OFF_HFS))[fi * 256 + t] = v; }
        }
    }
}

__device__ __forceinline__ void transpose_item(const float* W, int N, bf16_t* WT, int koff, int item, float* scr, int lane) {
    const int nblk = N / 32, kb = item / nblk, nb = item % nblk, k0 = 64 * kb, n0 = 32 * nb;
    float v[32];
#pragma unroll
    for (int i = 0; i < 32; ++i) { const int kk = 2 * i + (lane >> 5); v[i] = W[(size_t)(k0 + kk) * N + n0 + (lane & 31)]; }
#pragma unroll
    for (int i = 0; i < 32; ++i) { const int kk = 2 * i + (lane >> 5); scr[kk * 33 + (lane & 31)] = v[i]; }
    asm volatile("s_waitcnt lgkmcnt(0)" ::: "memory");
    const int c = lane & 7;
#pragma unroll
    for (int j = 0; j < 4; ++j) { const int n = (lane >> 3) + 8 * j; const float* q = scr + (8 * c) * 33 + n;
        u32x4 o; o.x = cvt_pk_bf16(q[0], q[33]); o.y = cvt_pk_bf16(q[2 * 33], q[3 * 33]); o.z = cvt_pk_bf16(q[4 * 33], q[5 * 33]); o.w = cvt_pk_bf16(q[6 * 33], q[7 * 33]);
        *(u32x4*)(WT + (size_t)(n0 + n) * 2048 + koff + k0 + 8 * c) = o; }
    asm volatile("s_waitcnt lgkmcnt(0)" ::: "memory");
}

__device__ __forceinline__ void phase1(const Params& P, unsigned char* smem, const int layer, const int cidx, const Chunk ck) {
    int tid_ = threadIdx.x; asm volatile("" : "+v"(tid_));
    const int tid = tid_, lane = tid & 63, wave = tid >> 6;
    if (cidx == 0) {
        float2* data = (float2*)smem; float2* tw = (float2*)(smem + FFT_DATA_BYTES);
        fft_init_tw(tw, tid);
        for (int it = blockIdx.x; it < 1024; it += gridDim.x) {
            const int o = it >> 9, c = it & 511;
            __syncthreads();
            const float* hf = (const float*)(P.ws + OFF_HFL) + ((size_t)(layer * 2 + o) * 512 + c) * 2 * 4096;
            const int t0 = tid * 8;
            const f32x4 f0 = *(const f32x4*)(hf + t0), f1 = *(const f32x4*)(hf + t0 + 4), b0 = *(const f32x4*)(hf + 4096 + t0), b1 = *(const f32x4*)(hf + 4096 + t0 + 4);
#pragma unroll
            for (int e = 0; e < 8; ++e) { const int t = t0 + e; const float fv = e < 4 ? f0[e] : f1[e - 4], bv = e < 4 ? b0[e] : b1[e - 4];
                data[PHYS(t)] = make_float2(fv, 0.f);
                if (t == 0) data[PHYS(4096)] = make_float2(0.f, 0.f); else data[PHYS(8192 - t)] = make_float2(bv, 0.f); }
            __syncthreads();
            fft_fwd_hi(data, tw, true, tid);
            fft_mid<false>(data, nullptr, (float2*)(P.ws + OFF_SPECL) + (size_t)(o * 512 + c) * 8192, 1.f / 8192.f, 0, tid);
        }
        for (int it = blockIdx.x; it < 64; it += gridDim.x) {
            const int o = it >> 5, c0 = (it & 31) * 16;
            __syncthreads();
            const int q = tid >> 5, t0 = (tid & 31) * 8, c = c0 + q;
            const float* hf = (const float*)(P.ws + OFF_HFS) + ((size_t)(layer * 2 + o) * 512 + c) * 2 * 256;
            const f32x4 f0 = *(const f32x4*)(hf + t0), f1 = *(const f32x4*)(hf + t0 + 4), b0 = *(const f32x4*)(hf + 256 + t0), b1 = *(const f32x4*)(hf + 256 + t0 + 4);
#pragma unroll
            for (int e = 0; e < 8; ++e) { const int t = t0 + e; const float fv = e < 4 ? f0[e] : f1[e - 4], bv = e < 4 ? b0[e] : b1[e - 4];
                data[PHYS(q * 512 + t)] = make_float2(fv, 0.f);
                if (t == 0) data[PHYS(q * 512 + 256)] = make_float2(0.f, 0.f); else data[PHYS(q * 512 + 512 - t)] = make_float2(bv, 0.f); }
            __syncthreads();
            fft_fwd_hi(data, tw, false, tid);
            fft_mid<false>(data, nullptr, (float2*)(P.ws + OFF_SPECS) + (size_t)(o * 512 + c0) * 512, 1.f / 512.f, 0, tid);
        }
        __syncthreads();
        float* scr = (float*)smem + wave * (64 * 33);
        const int gw = blockIdx.x * 8 + wave, NGW = gridDim.x * 8;
        for (int it = gw; it < 17408; it += NGW) {
            int r = it;
            if (r < 13312) { transpose_item(P.in[I_WIN] + (size_t)layer * 2048 * INW, INW, (bf16_t*)(P.ws + OFF_WTIN), 0, r, scr, lane); continue; } r -= 13312;
            if (r < 2048) { transpose_item(P.in[I_WOUT] + (size_t)layer * 2048 * 2048, 2048, (bf16_t*)(P.ws + OFF_WTOUT), 0, r, scr, lane); continue; } r -= 2048;
            if (r < 768) { transpose_item(P.in[I_WUA] + (size_t)layer * 768 * 2048, 2048, (bf16_t*)(P.ws + OFF_WTUP), 0, r, scr, lane); continue; } r -= 768;
            if (r < 512) { transpose_item(P.in[I_WUB] + (size_t)layer * 512 * 2048, 2048, (bf16_t*)(P.ws + OFF_WTUP), 768, r, scr, lane); continue; } r -= 512;
            transpose_item(P.in[I_WUC] + (size_t)layer * 768 * 2048, 2048, (bf16_t*)(P.ws + OFF_WTUP), 1280, r, scr, lane);
        }
    }
    const float* nw = P.in[I_NW] + layer * D;
    for (int it = blockIdx.x; it < ck.ntok / 64; it += gridDim.x) {
        const int g0 = ck.tok0 + it * 64;
        const float* md = (const float*)(P.ws + OFF_MOD) + ((size_t)layer * 9 + cond_of(g0)) * 6144;
        f32x4 ma[8], mb[8];
#pragma unroll
        for (int j = 0; j < 8; ++j) { const int k = lane * 4 + 256 * j; const f32x4 w = *(const f32x4*)(nw + k), sc = *(const f32x4*)(md + 2048 + k); mb[j] = *(const f32x4*)(md + k); ma[j] = w * (1.f + sc); }
#pragma unroll 1
        for (int i = 0; i < 4; ++i) {
            const int r = it * 64 + wave * 8 + 2 * i, g = ck.tok0 + r;
            const float* x = (layer == 0) ? (g < NCTXTOK ? P.in[I_XP] + (size_t)g * D : P.in[I_XS] + (size_t)(g - NCTXTOK) * D) : P.out + (size_t)g * D;
            f32x4 v0[8], v1[8]; float s0 = 0.f, s1 = 0.f;
#pragma unroll
            for (int j = 0; j < 8; ++j) { v0[j] = *(const f32x4*)(x + lane * 4 + 256 * j); v1[j] = *(const f32x4*)(x + D + lane * 4 + 256 * j); }
#pragma unroll
            for (int j = 0; j < 8; ++j) { s0 += v0[j][0] * v0[j][0] + v0[j][1] * v0[j][1] + v0[j][2] * v0[j][2] + v0[j][3] * v0[j][3]; s1 += v1[j][0] * v1[j][0] + v1[j][1] * v1[j][1] + v1[j][2] * v1[j][2] + v1[j][3] * v1[j][3]; }
            const float r0 = rsqrtf(wave_sum(s0) * (1.f / D) + 1e-6f), r1 = rsqrtf(wave_sum(s1) * (1.f / D) + 1e-6f);
            bf16_t* h = (bf16_t*)(P.ws + OFF_H) + (size_t)r * D;
#pragma unroll
            for (int j = 0; j < 8; ++j) { const int k = lane * 4 + 256 * j;
                const f32x4 y0 = v0[j] * r0 * ma[j] + mb[j], y1 = v1[j] * r1 * ma[j] + mb[j];
                u32x2 o0, o1; o0.x = cvt_pk_bf16(y0[0], y0[1]); o0.y = cvt_pk_bf16(y0[2], y0[3]); o1.x = cvt_pk_bf16(y1[0], y1[1]); o1.y = cvt_pk_bf16(y1[2], y1[3]);
                *(u32x2*)(h + k) = o0; *(u32x2*)(h + D + k) = o1; }
        }
    }
}

__device__ __forceinline__ void hy_transpose_item(const Params& P, float* s, const int layer, const Chunk ck, int item, int tid) {
    const int tb = item >> 3, cb = item & 7, t0 = tb * 64;
    const int ctxrows = ck.nctxb * 256;
    const int Ls = (t0 < ctxrows) ? 256 : 4096; const int tin = (t0 < ctxrows) ? (t0 & 255) : ((t0 - ck.lat_row0) & 4095);
    const bool first = (tin == 0), lastb = (tin + 64 == Ls);
    const bf16_t* U = (const bf16_t*)(P.ws + OFF_U7);
    for (int idx = tid; idx < 66 * 32; idx += NTHREADS) { const int rr = idx >> 5, ch = idx & 31;
        const bool valid = !((rr == 0 && first) || (rr == 65 && lastb));
        u32x4 w = (u32x4){0u, 0u, 0u, 0u};
        if (valid) w = *(const u32x4*)(U + (size_t)(t0 - 1 + rr) * U7W + 2048 + cb * 256 + ch * 8);
        float* d = s + rr * 257 + ch * 8; d[0] = bf_lo(w.x); d[1] = bf_hi(w.x); d[2] = bf_lo(w.y); d[3] = bf_hi(w.y); d[4] = bf_lo(w.z); d[5] = bf_hi(w.z); d[6] = bf_lo(w.w); d[7] = bf_hi(w.w); }
    __syncthreads();
    const int tch = tid & 7;
#pragma unroll
    for (int j = 0; j < 4; ++j) {
        const int col = (tid >> 3) + 64 * j, cc = cb * 256 + col;
        float o[8];
        if (cb < 6) { const float* cw = P.in[I_HCW] + (size_t)layer * 3 * 1536; const float w0 = cw[cc], w1 = cw[1536 + cc], w2 = cw[3072 + cc], bb = P.in[I_HCB][layer * 1536 + cc];
#pragma unroll
            for (int i = 0; i < 8; ++i) { const int t = tch * 8 + i; o[i] = bb + w0 * s[t * 257 + col] + w1 * s[(t + 1) * 257 + col] + w2 * s[(t + 2) * 257 + col]; } }
        else {
#pragma unroll
            for (int i = 0; i < 8; ++i) { const int t = tch * 8 + i; o[i] = s[(t + 1) * 257 + col]; } }
        u32x4 w; w.x = cvt_pk_bf16(o[0], o[1]); w.y = cvt_pk_bf16(o[2], o[3]); w.z = cvt_pk_bf16(o[4], o[5]); w.w = cvt_pk_bf16(o[6], o[7]);
        *(u32x4*)((bf16_t*)(P.ws + OFF_H) + (size_t)cc * ck.ntok + t0 + tch * 8) = w;
    }
    __syncthreads();
}

typedef short s16x4 __attribute__((ext_vector_type(4)));
struct AttnSt { float mrun, lsum; f32x4 o[4]; };
template <int MASK>
__device__ __forceinline__ void attn_tile(AttnSt& st_, const bf16_t* Ks, const bf16_t* Vs, const bf16x8 (&qf)[2], const float* rpbs, int qrow, int ttok0, int fr, int fq) {
    const float C1 = 0.125f * 1.4426950408889634f, LOG2E = 1.4426950408889634f;
    f32x4 sc[4];
#pragma unroll
    for (int st = 0; st < 4; ++st) { sc[st] = (f32x4){0.f, 0.f, 0.f, 0.f};
#pragma unroll
        for (int ks = 0; ks < 2; ++ks) { const bf16x8 a = *(const bf16x8*)(Ks + (st * 16 + fr) * 72 + ks * 32 + fq * 8); sc[st] = __builtin_amdgcn_mfma_f32_16x16x32_bf16(a, qf[ks], sc[st], 0, 0, 0); } }
    float mx = st_.mrun;
    if (MASK == 0) {
#pragma unroll
        for (int st = 0; st < 4; ++st)
#pragma unroll
            for (int i = 0; i < 4; ++i) { const float sv = sc[st][i] * C1; sc[st][i] = sv; mx = __builtin_fmaxf(mx, sv); }
    } else if (MASK == 1) {
        const int dl = qrow - ttok0 - fq * 4 + 128;
#pragma unroll
        for (int st = 0; st < 4; ++st)
#pragma unroll
            for (int i = 0; i < 4; ++i) { const bool ok = (unsigned)(dl - (st * 16 + i)) <= 256u; const float sv = ok ? sc[st][i] * C1 : -1e30f; sc[st][i] = sv; mx = __builtin_fmaxf(mx, sv); }
    } else {
        const int kr = ttok0 >> 6, r = qrow >> 6, w = qrow & 63; int rs = r - 4; rs = rs < 0 ? 0 : (rs > 56 ? 56 : rs); int cs = w - 8; cs = cs < 0 ? 0 : (cs > 48 ? 48 : cs);
        const bool rowok = (kr >= rs) && (kr < rs + 8);
        const int kk0 = fq * 4, brow = (kr - r + 7) * 31 - w + 15 + kk0, cl = kk0 - cs;
        float bias[16];
#pragma unroll
        for (int st = 0; st < 4; ++st)
#pragma unroll
            for (int i = 0; i < 4; ++i) { const bool ok = rowok && ((unsigned)(cl + st * 16 + i) < 16u); bias[st * 4 + i] = rpbs[ok ? brow + st * 16 + i : 0]; }
#pragma unroll
        for (int st = 0; st < 4; ++st)
#pragma unroll
            for (int i = 0; i < 4; ++i) { const bool ok = rowok && ((unsigned)(cl + st * 16 + i) < 16u); const float sv = ok ? sc[st][i] * C1 + bias[st * 4 + i] * LOG2E : -1e30f; sc[st][i] = sv; mx = __builtin_fmaxf(mx, sv); }
    }
    mx = __builtin_fmaxf(mx, __shfl_xor(mx, 16)); mx = __builtin_fmaxf(mx, __shfl_xor(mx, 32));
    const float alpha = __builtin_amdgcn_exp2f(st_.mrun - mx); st_.mrun = mx; float ls = st_.lsum * alpha;
#pragma unroll
    for (int dt = 0; dt < 4; ++dt) st_.o[dt] *= alpha;
#pragma unroll
    for (int st = 0; st < 4; ++st)
#pragma unroll
        for (int i = 0; i < 4; ++i) { const float p = __builtin_amdgcn_exp2f(sc[st][i] - mx); ls += p; sc[st][i] = p; }
    st_.lsum = ls;
#pragma unroll
    for (int k2 = 0; k2 < 2; ++k2) {
        u32x4 pw; pw.x = cvt_pk_bf16(sc[2 * k2][0], sc[2 * k2][1]); pw.y = cvt_pk_bf16(sc[2 * k2][2], sc[2 * k2][3]); pw.z = cvt_pk_bf16(sc[2 * k2 + 1][0], sc[2 * k2 + 1][1]); pw.w = cvt_pk_bf16(sc[2 * k2 + 1][2], sc[2 * k2 + 1][3]);
        const bf16x8 pb = __builtin_bit_cast(bf16x8, pw);
#pragma unroll
        for (int dt = 0; dt < 4; ++dt) { const bf16_t* vp = Vs + (32 * k2 + fq * 4 + (fr >> 2)) * 72 + dt * 16 + 4 * (fr & 3);
            const s16x4 v0 = __builtin_amdgcn_ds_read_tr16_b64_v4i16((LAS s16x4*)vp), v1 = __builtin_amdgcn_ds_read_tr16_b64_v4i16((LAS s16x4*)(vp + 16 * 72));
            bf16x8 aw; aw[0] = v0[0]; aw[1] = v0[1]; aw[2] = v0[2]; aw[3] = v0[3]; aw[4] = v1[0]; aw[5] = v1[1]; aw[6] = v1[2]; aw[7] = v1[3];
            st_.o[dt] = __builtin_amdgcn_mfma_f32_16x16x32_bf16(aw, pb, st_.o[dt], 0, 0, 0); }
    }
}
template <int NG>
__device__ __forceinline__ void attn_item(const Params& P, unsigned char* smem, const int layer, const Chunk ck, int kind, int b, int hh_, int qb) {
    int tid_ = threadIdx.x; asm volatile("" : "+v"(tid_));
    const int tid = tid_, lane = tid & 63, wave = tid >> 6, fr = lane & 15, fq = lane >> 4;
    bf16_t* KV = (bf16_t*)smem;
    float* rpbs = (float*)(smem + 4 * 64 * 72 * 2);
    bf16_t* U = (bf16_t*)(P.ws + OFF_U7);
    const bool lat = kind < 2, isA = (NG == 3);
    const int seq_row0 = lat ? ck.lat_row0 + (b - ck.latb0) * 4096 : b * 256;
    const int QR = isA ? 128 : 256;
    const int q0 = qb * QR;
    const int kh = hh_;
    const int kcol = isA ? 768 + kh * 64 : 4864 + kh * 64, vcol = isA ? 1024 + kh * 64 : 5632 + kh * 64;
    int lt0, nlt;
    if (kind == 0) { const int a = q0 - 128 < 0 ? 0 : q0 - 128, e = q0 + 256 > 4096 ? 4096 : q0 + 256; lt0 = a; nlt = (e - a) >> 6; }
    else if (kind == 1) { const int r0 = q0 >> 6; int rs0 = r0 - 4; rs0 = rs0 < 0 ? 0 : (rs0 > 56 ? 56 : rs0); int rs1 = r0 - 1; rs1 = rs1 < 0 ? 0 : (rs1 > 56 ? 56 : rs1); lt0 = rs0 * 64; nlt = rs1 + 8 - rs0; }
    else { lt0 = 0; nlt = 4; }
    const int nct = lat ? 8 : 0, ntiles = nct + nlt;
    const int nplain = lat ? nct : ntiles;
    const float* cK = isA ? P.in[I_CAK] : P.in[I_CCK]; const float* cV = isA ? P.in[I_CAV] : P.in[I_CCV]; const int HK = isA ? 4 : 12;
    const float2* rope = (const float2*)(P.ws + OFF_ROPE);
    const int skey = tid >> 3, spc = tid & 7;
    u32x4 raw[4];
#define ATT_ISSUE(ti_) do { if ((ti_) < nct) { \
            const size_t off_ = ((((size_t)b * 2 + layer) * PAST + (size_t)(ti_) * 64 + skey) * HK + kh) * 64 + spc * 8; \
            raw[0] = *(const u32x4*)(cK + off_); raw[1] = *(const u32x4*)(cK + off_ + 4); raw[2] = *(const u32x4*)(cV + off_); raw[3] = *(const u32x4*)(cV + off_ + 4); \
        } else { const int tok_ = lt0 + ((ti_) - nct) * 64 + skey; const bf16_t* rowp_ = U + (size_t)(seq_row0 + tok_) * U7W; \
            raw[0] = *(const u32x4*)(rowp_ + kcol + spc * 8); raw[1] = *(const u32x4*)(rowp_ + vcol + spc * 8); \
            if (kind == 0) raw[2] = *(const u32x4*)(rowp_ + kcol + (spc ^ 4) * 8); } } while (0)
#define ATT_COMMIT(ti_) do { bf16_t* Ks_ = KV + ((ti_) & 1) * (2 * 64 * 72); bf16_t* Vs_ = Ks_ + 64 * 72; u32x4 kw, vw; \
        if ((ti_) < nct) { \
            const f32x4 k0 = __builtin_bit_cast(f32x4, raw[0]), k1 = __builtin_bit_cast(f32x4, raw[1]), v0 = __builtin_bit_cast(f32x4, raw[2]), v1 = __builtin_bit_cast(f32x4, raw[3]); \
            kw.x = cvt_pk_bf16(k0[0], k0[1]); kw.y = cvt_pk_bf16(k0[2], k0[3]); kw.z = cvt_pk_bf16(k1[0], k1[1]); kw.w = cvt_pk_bf16(k1[2], k1[3]); \
            vw.x = cvt_pk_bf16(v0[0], v0[1]); vw.y = cvt_pk_bf16(v0[2], v0[3]); vw.z = cvt_pk_bf16(v1[0], v1[1]); vw.w = cvt_pk_bf16(v1[2], v1[3]); \
        } else { kw = raw[0]; vw = raw[1]; \
            if (kind == 0) { const u32x4 pw = raw[2]; const int tok = lt0 + ((ti_) - nct) * 64 + skey; const int rr = tok >> 6, cc = tok & 63; const bool lo = spc < 4; \
                _Pragma("unroll") for (int e = 0; e < 4; ++e) { float r2[2]; \
                    _Pragma("unroll") for (int hh = 0; hh < 2; ++hh) { const int i = (spc & 3) * 8 + 2 * e + hh; const float2 cs = (i < 16) ? rope[rr * 16 + i] : rope[cc * 16 + i - 16]; \
                        const float mine = hh ? bf_hi(kw[e]) : bf_lo(kw[e]), oth = hh ? bf_hi(pw[e]) : bf_lo(pw[e]); \
                        r2[hh] = lo ? (mine * cs.x - oth * cs.y) : (oth * cs.y + mine * cs.x); } \
                    kw[e] = cvt_pk_bf16(r2[0], r2[1]); } } } \
        *(u32x4*)(Ks_ + skey * 72 + spc * 8) = kw; *(u32x4*)(Vs_ + skey * 72 + spc * 8) = vw; } while (0)
    __syncthreads();
    ATT_ISSUE(0);
    if (kind == 1) { for (int i = tid; i < 465; i += NTHREADS) rpbs[i] = P.in[I_RPB][((size_t)layer * 12 + kh) * 465 + i]; }
    int qrow[NG], hd[NG];
    bf16x8 qf[NG][2];
    AttnSt S[NG];
#pragma unroll
    for (int g = 0; g < NG; ++g) {
        qrow[g] = isA ? q0 + wave * 16 + fr : q0 + g * 128 + wave * 16 + fr;
        hd[g] = isA ? kh * 3 + g : kh;
        const int qcol = isA ? hd[g] * 64 : 4096 + hd[g] * 64;
        const bf16_t* qp = U + (size_t)(seq_row0 + qrow[g]) * U7W + qcol + fq * 8;
        u32x4 a0 = *(const u32x4*)qp, a1 = *(const u32x4*)(qp + 32);
        if (kind == 0) {
            const int rr = qrow[g] >> 6, cc = qrow[g] & 63;
            float x1[8], x2[8];
#pragma unroll
            for (int e = 0; e < 4; ++e) { x1[2 * e] = bf_lo(a0[e]); x1[2 * e + 1] = bf_hi(a0[e]); x2[2 * e] = bf_lo(a1[e]); x2[2 * e + 1] = bf_hi(a1[e]); }
#pragma unroll
            for (int j = 0; j < 8; ++j) { const int i = fq * 8 + j; const float2 cs = (i < 16) ? rope[rr * 16 + i] : rope[cc * 16 + i - 16];
                const float o1 = x1[j] * cs.x - x2[j] * cs.y, o2 = x1[j] * cs.y + x2[j] * cs.x; x1[j] = o1; x2[j] = o2; }
#pragma unroll
            for (int e = 0; e < 4; ++e) { a0[e] = cvt_pk_bf16(x1[2 * e], x1[2 * e + 1]); a1[e] = cvt_pk_bf16(x2[2 * e], x2[2 * e + 1]); }
        }
        qf[g][0] = __builtin_bit_cast(bf16x8, a0); qf[g][1] = __builtin_bit_cast(bf16x8, a1);
        if (isA) { S[g].mrun = P.in[I_SINK][layer * 12 + hd[g]] * 1.4426950408889634f; S[g].lsum = (fq == 0) ? 1.f : 0.f; } else { S[g].mrun = -1e30f; S[g].lsum = 0.f; }
#pragma unroll
        for (int dt = 0; dt < 4; ++dt) S[g].o[dt] = (f32x4){0.f, 0.f, 0.f, 0.f};
    }
    int ti = 0;
    for (; ti < nplain; ++ti) {
        ATT_COMMIT(ti);
        __syncthreads();
        if (ti + 1 < ntiles) ATT_ISSUE(ti + 1);
        const bf16_t* Ks = KV + (ti & 1) * (2 * 64 * 72);
#pragma unroll
        for (int g = 0; g < NG; ++g) attn_tile<0>(S[g], Ks, Ks + 64 * 72, qf[g], rpbs, qrow[g], 0, fr, fq);
    }
    if (kind == 0) {
        for (; ti < ntiles; ++ti) {
            ATT_COMMIT(ti);
            __syncthreads();
            if (ti + 1 < ntiles) ATT_ISSUE(ti + 1);
            const bf16_t* Ks = KV + (ti & 1) * (2 * 64 * 72);
#pragma unroll
            for (int g = 0; g < NG; ++g) attn_tile<1>(S[g], Ks, Ks + 64 * 72, qf[g], rpbs, qrow[g], lt0 + (ti - nct) * 64, fr, fq);
        }
    } else {
        for (; ti < ntiles; ++ti) {
            ATT_COMMIT(ti);
            __syncthreads();
            if (ti + 1 < ntiles) ATT_ISSUE(ti + 1);
            const bf16_t* Ks = KV + (ti & 1) * (2 * 64 * 72);
#pragma unroll
            for (int g = 0; g < NG; ++g) attn_tile<2>(S[g], Ks, Ks + 64 * 72, qf[g], rpbs, qrow[g], lt0 + (ti - nct) * 64, fr, fq);
        }
    }
#undef ATT_ISSUE
#undef ATT_COMMIT
#pragma unroll
    for (int g = 0; g < NG; ++g) {
        float lsum = S[g].lsum;
        lsum += __shfl_xor(lsum, 16); lsum += __shfl_xor(lsum, 32);
        const float inv = __builtin_amdgcn_rcpf(lsum);
        const int gcol = isA ? 1280 + hd[g] * 64 : 6400 + hd[g] * 64;
        bf16_t* gp = U + (size_t)(seq_row0 + qrow[g]) * U7W + gcol + fq * 4;
#pragma unroll
        for (int dt = 0; dt < 4; ++dt) { const u32x2 gw = *(const u32x2*)(gp + dt * 16);
            const float g0 = bf_lo(gw.x), g1 = bf_hi(gw.x), g2 = bf_lo(gw.y), g3 = bf_hi(gw.y);
            u32x2 ow; ow.x = cvt_pk_bf16(S[g].o[dt][0] * inv * g0 * sigmoidf_(g0), S[g].o[dt][1] * inv * g1 * sigmoidf_(g1)); ow.y = cvt_pk_bf16(S[g].o[dt][2] * inv * g2 * sigmoidf_(g2), S[g].o[dt][3] * inv * g3 * sigmoidf_(g3));
            *(u32x2*)(gp + dt * 16) = ow; }
    }
}

__device__ __forceinline__ void phase3a(const Params& P, unsigned char* smem, const int layer, const Chunk ck) {
    int tid_ = threadIdx.x; asm volatile("" : "+v"(tid_));
    const int tid = tid_;
    const int n_latC = ck.nlatb * 12 * 16, n_latA = ck.nlatb * 4 * 32, n_ctxC = ck.nctxb * 12, n_ctxA = ck.nctxb * 4 * 2;
    const int n_attn = n_latC + n_latA + n_ctxC + n_ctxA;
    const int n_tr = (ck.ntok / 64) * 8;
    for (int it = blockIdx.x; it < n_attn + n_tr; it += gridDim.x) {
        if (it < n_attn) {
            int r = it;
            if (r < n_latC) { const int b = ck.latb0 + r / 192; r %= 192; attn_item<2>(P, smem, layer, ck, 1, b, r >> 4, r & 15); }
            else if ((r -= n_latC) < n_latA) { const int b = ck.latb0 + r / 128; r %= 128; attn_item<3>(P, smem, layer, ck, 0, b, r >> 5, r & 31); }
            else if ((r -= n_latA) < n_ctxC) { attn_item<2>(P, smem, layer, ck, 3, r / 12, r % 12, 0); }
            else { r -= n_ctxC; attn_item<3>(P, smem, layer, ck, 2, r >> 3, (r >> 1) & 3, r & 1); }
        } else {
            __syncthreads();
            hy_transpose_item(P, (float*)smem, layer, ck, it - n_attn, tid);
        }
    }
}

__device__ __forceinline__ void phase3b(const Params& P, unsigned char* smem, const int layer, const Chunk ck) {
    int tid_ = threadIdx.x; asm volatile("" : "+v"(tid_));
    const int tid = tid_;
    float2* data = (float2*)smem; float2* tw = (float2*)(smem + FFT_DATA_BYTES);
    fft_init_tw(tw, tid);
    const bf16_t* T = (const bf16_t*)(P.ws + OFF_H);
    bf16_t* U = (bf16_t*)(P.ws + OFF_U7);
    const int npair = ck.nlatb / 2, nlat_items = npair * 512, nctx_items = ck.nctxb ? 512 : 0;
    const size_t nt = (size_t)ck.ntok;
    for (int it = blockIdx.x; it < nlat_items + nctx_items; it += gridDim.x) {
        const bool lat = it < nlat_items;
        const int c = lat ? (it & 511) : ((it - nlat_items) & 511);
        const int pr = lat ? (it >> 9) : 0;
        const bf16_t* tv = T + (size_t)c * nt; const bf16_t* tx1 = T + (size_t)(512 + c) * nt; const bf16_t* tx2 = T + (size_t)(1024 + c) * nt; const bf16_t* tg = T + (size_t)(1536 + c) * nt;
        const float2* sp0 = lat ? (const float2*)(P.ws + OFF_SPECL) + (size_t)c * 8192 : (const float2*)(P.ws + OFF_SPECS) + (size_t)c * 512;
        const float2* sp1 = lat ? sp0 + (size_t)512 * 8192 : sp0 + (size_t)512 * 512;
        const int spmask = lat ? 8191 : 511;
        __syncthreads();
#define HY_MAP(idx, valid, rA, rB) do { if (lat) { valid = (idx) < 4096; rA = ck.lat_row0 + pr * 8192 + (idx); rB = rA + 4096; } \
                                        else { const int q_ = (idx) >> 9, t_ = (idx) & 511; valid = t_ < 256; rA = q_ * 512 + t_; rB = rA + 256; } } while (0)
#pragma unroll
        for (int i = 0; i < 2; ++i) { const int idx = (tid + 512 * i) * 8; bool valid; int rA, rB; HY_MAP(idx, valid, rA, rB);
            float2* dp = data + PHYS(idx);
            if (valid) { const u32x4 a = *(const u32x4*)(tv + rA), bq = *(const u32x4*)(tv + rB);
#pragma unroll
                for (int e = 0; e < 4; ++e) { dp[2 * e] = make_float2(bf_lo(a[e]), bf_lo(bq[e])); dp[2 * e + 1] = make_float2(bf_hi(a[e]), bf_hi(bq[e])); } }
            else {
#pragma unroll
                for (int e = 0; e < 8; ++e) dp[e] = make_float2(0.f, 0.f); } }
        __syncthreads();
        fft_fwd_hi(data, tw, lat, tid);
        fft_mid<true>(data, sp0, nullptr, 1.f, spmask, tid);
        fft_inv_hi(data, tw, lat, tid);
#pragma unroll
        for (int i = 0; i < 2; ++i) { const int idx = (tid + 512 * i) * 8; bool valid; int rA, rB; HY_MAP(idx, valid, rA, rB);
            float2* dp = data + PHYS(idx);
            if (valid) { const u32x4 a = *(const u32x4*)(tx1 + rA), bq = *(const u32x4*)(tx1 + rB);
#pragma unroll
                for (int e = 0; e < 4; ++e) { float2 v0 = dp[2 * e], v1 = dp[2 * e + 1]; dp[2 * e] = make_float2(v0.x * bf_lo(a[e]), v0.y * bf_lo(bq[e])); dp[2 * e + 1] = make_float2(v1.x * bf_hi(a[e]), v1.y * bf_hi(bq[e])); } }
            else {
#pragma unroll
                for (int e = 0; e < 8; ++e) dp[e] = make_float2(0.f, 0.f); } }
        __syncthreads();
        fft_fwd_hi(data, tw, lat, tid);
        fft_mid<true>(data, sp1, nullptr, 1.f, spmask, tid);
        fft_inv_hi(data, tw, lat, tid);
#pragma unroll
        for (int i = 0; i < 2; ++i) { const int idx = (tid + 512 * i) * 8; bool valid; int rA, rB; HY_MAP(idx, valid, rA, rB);
            const float2* dp = data + PHYS(idx);
            if (valid) { const u32x4 xa = *(const u32x4*)(tx2 + rA), xb = *(const u32x4*)(tx2 + rB), ga = *(const u32x4*)(tg + rA), gb = *(const u32x4*)(tg + rB);
#pragma unroll
                for (int e = 0; e < 8; ++e) { const float2 v = dp[e];
                    const float x2a = (e & 1) ? bf_hi(xa[e >> 1]) : bf_lo(xa[e >> 1]), x2b = (e & 1) ? bf_hi(xb[e >> 1]) : bf_lo(xb[e >> 1]);
                    const float gA = (e & 1) ? bf_hi(ga[e >> 1]) : bf_lo(ga[e >> 1]), gB = (e & 1) ? bf_hi(gb[e >> 1]) : bf_lo(gb[e >> 1]);
                    U[(size_t)(rA + e) * U7W + 3584 + c] = f2bf(v.x * x2a * gA * sigmoidf_(gA));
                    U[(size_t)(rB + e) * U7W + 3584 + c] = f2bf(v.y * x2b * gB * sigmoidf_(gB)); } } }
#undef HY_MAP
    }
}

__device__ __forceinline__ void phase_final(const Params& P) {
    int tid_ = threadIdx.x; asm volatile("" : "+v"(tid_));
    const int tid = tid_, lane = tid & 63, wave = tid >> 6;
    const float* fw = P.in[I_FNW];
    for (int it = blockIdx.x; it < 40960 / 8; it += gridDim.x) {
        const int g = it * 8 + wave; float* x = P.out + (size_t)g * D;
        f32x4 v[8]; float ss = 0.f;
#pragma unroll
        for (int j = 0; j < 8; ++j) { v[j] = *(const f32x4*)(x + lane * 4 + 256 * j); ss += v[j][0] * v[j][0] + v[j][1] * v[j][1] + v[j][2] * v[j][2] + v[j][3] * v[j][3]; }
        const float rstd = rsqrtf(wave_sum(ss) * (1.f / D) + 1e-6f);
#pragma unroll
        for (int j = 0; j < 8; ++j) { const int k = lane * 4 + 256 * j; const f32x4 w = *(const f32x4*)(fw + k); *(f32x4*)(x + k) = v[j] * rstd * w; }
    }
}

__global__ void __launch_bounds__(NTHREADS, 2) fwd_megakernel(Params P) {
    extern __shared__ __attribute__((aligned(16))) unsigned char smem[];
    cg::grid_group grid = cg::this_grid();
#ifndef PMASK
#define PMASK 0xff
#endif
    if (PMASK & 1) phase0(P, smem);
    grid.sync();
    if (PMASK & 1) phase0b(P, smem);
    grid.sync();
    for (int layer = 0; layer < 2; ++layer) {
        for (int c = 0; c < 2; ++c) {
            const Chunk ck = get_chunk(c);
            if (PMASK & 2) phase1(P, smem, layer, c, ck);
            grid.sync();
            if (PMASK & 4) gemm_phase<2>((LAS unsigned char*)smem, P, layer, ck);
            grid.sync();
            if (PMASK & 8) phase3a(P, smem, layer, ck);
            grid.sync();
            if (PMASK & 16) phase3b(P, smem, layer, ck);
            grid.sync();
            if (PMASK & 32) gemm_phase<4>((LAS unsigned char*)smem, P, layer, ck);
            grid.sync();
            if (PMASK & 64) gemm_phase<5>((LAS unsigned char*)smem, P, layer, ck);
            grid.sync();
        }
    }
    if (PMASK & 128) phase_final(P);
}

extern "C" void kernel_launch(void* const* d_in, const int* in_sizes, int n_in, void* d_out, int out_size, void* d_ws, size_t ws_size, hipStream_t stream) {
    static int grid_blocks = 0;
    if (grid_blocks == 0) {
        if (n_in != 29 || ws_size < WS_END) { fprintf(stderr, "kernel_launch: need 29 inputs and %zu bytes of workspace (got %d, %zu)\n", (size_t)WS_END, n_in, ws_size); grid_blocks = -1; return; }
        int dev = 0, cus = 0, per_cu = 0;
        hipGetDevice(&dev);
        hipDeviceGetAttribute(&cus, hipDeviceAttributeMultiprocessorCount, dev);
        if (hipFuncSetAttribute((const void*)fwd_megakernel, hipFuncAttributeMaxDynamicSharedMemorySize, LDS_BYTES) != hipSuccess) { fprintf(stderr, "kernel_launch: hipFuncSetAttribute failed\n"); grid_blocks = -1; return; }
        hipOccupancyMaxActiveBlocksPerMultiprocessor(&per_cu, (const void*)fwd_megakernel, NTHREADS, LDS_BYTES);
        if (per_cu < 1) per_cu = 1;
        grid_blocks = cus * per_cu;
        (void)hipGetLastError();
    }
    if (grid_blocks < 0) return;
    Params p{};
    for (int i = 0; i < 29; ++i) p.in[i] = (const float*)d_in[i];
    p.out = (float*)d_out; p.ws = (unsigned char*)d_ws;
    void* args[] = {&p};
    hipError_t e = hipLaunchCooperativeKernel((const void*)fwd_megakernel, dim3(grid_blocks), dim3(NTHREADS), args, LDS_BYTES, stream);
    if (e != hipSuccess) fprintf(stderr, "cooperative launch failed: %s (grid %d)\n", hipGetErrorString(e), grid_blocks);
}
```
